# Optimizing an MI355X kernel written in HIP

```python
import numpy as np
import jax
import jax.numpy as jnp
from jax import lax

D_MODEL = 2048
BATCH = 1
SEQ = 8192
DEPTH = 4

CHUNK = 64
EPS = 1e-6

HG_HEADS = 8
HG_DK = 128
HG_DV = 128
HG_WIDTH = HG_HEADS * HG_DV
HG_COLS = (HG_HEADS * HG_DK, HG_HEADS * HG_DK, HG_WIDTH, HG_WIDTH)

RW_HEADS = 16
RW_N = 64
RW_WIDTH = RW_HEADS * RW_N
RW_DECAY_LORA = 64
RW_AAA_LORA = 64
RW_GATE_LORA = 160
RW_GN_EPS = 64e-5
RW_COLS = (RW_WIDTH, RW_WIDTH, RW_WIDTH, RW_DECAY_LORA, RW_AAA_LORA, RW_GATE_LORA)

ML_HEADS = 4
ML_DQK = 128
ML_DV = 256
ML_GATE_CAP = 15.0
ML_COLS = (ML_HEADS * ML_DQK, ML_HEADS * ML_DQK, ML_HEADS * ML_DV, ML_HEADS, ML_HEADS, ML_HEADS * ML_DV)

MB_HEADS = 16
MB_HEADDIM = 64
MB_D_INNER = MB_HEADS * MB_HEADDIM
MB_D_STATE = 128
MB_GROUPS = 2
MB_CONV = 4
MB_XBC = MB_D_INNER + 2 * MB_GROUPS * MB_D_STATE
MB_COLS = (MB_D_INNER, MB_XBC, MB_HEADS)

E_IN_EVEN = sum(HG_COLS) + sum(RW_COLS)
E_IN_ODD = sum(ML_COLS) + sum(MB_COLS)
MIX_WIDTH_EVEN = HG_WIDTH + RW_WIDTH
MIX_WIDTH_ODD = ML_HEADS * ML_DV + MB_D_INNER
D_FF = -((-8 * D_MODEL) // (3 * 256)) * 256

kernel_name = 'hybrid_hgrn2_rwkv7_mlstm_mamba2_trunk'


def rms_norm(x, g):
    xf = x.astype(jnp.float32)
    y = xf * lax.rsqrt(jnp.mean(xf * xf, axis=-1, keepdims=True) + EPS)
    return (y * g).astype(x.dtype)


def head_rmsnorm(t, n_heads, g):
    b, s, w = t.shape
    th = t.reshape(b, s, n_heads, w // n_heads)
    th = th * lax.rsqrt(jnp.mean(th * th, axis=-1, keepdims=True) + EPS)
    return th.reshape(b, s, w) * g


def head_layernorm(t, w, bias, eps):
    mu = jnp.mean(t, axis=-1, keepdims=True)
    var = jnp.mean(jnp.square(t - mu), axis=-1, keepdims=True)
    y = (t - mu) * lax.rsqrt(var + eps)
    return y.reshape(t.shape[0], t.shape[1], -1) * w + bias


def split_cols(p, sizes):
    return jnp.split(p, np.cumsum(sizes)[:-1].tolist(), axis=-1)


def token_shift(p):
    return jnp.pad(p, ((0, 0), (1, 0), (0, 0)))[:, :-1]


def causal_dwconv(x, w, bias):
    y = lax.conv_general_dilated(x, w.astype(x.dtype)[:, None, :], window_strides=(1,),
                                 padding=[(w.shape[0] - 1, 0)],
                                 dimension_numbers=('NWC', 'WIO', 'NWC'),
                                 feature_group_count=x.shape[-1])
    return y + bias


def causal_mask():
    return jnp.tril(jnp.ones((CHUNK, CHUNK), dtype=bool))


def chunk_seq(t, n_feat=1):
    b, s = t.shape[:2]
    t = t.reshape(b, s // CHUNK, CHUNK, *t.shape[2:])
    t = jnp.moveaxis(t, 2, t.ndim - 1 - n_feat)
    return jnp.moveaxis(t, 1, 0)


def unchunk_seq(t):
    t = jnp.moveaxis(t, 0, 1)
    t = jnp.moveaxis(t, -2, 2)
    b, nc, l = t.shape[:3]
    return t.reshape(b, nc * l, -1)


def hgrn2_chunked(qc, kc, vc, gc):
    mask = causal_mask()

    def step(state, inp):
        q_, k_, v_, g_ = inp
        bcum = jnp.cumsum(g_, axis=-2)
        rel = jnp.where(mask[:, :, None], bcum[..., :, None, :] - bcum[..., None, :, :], -jnp.inf)
        scores = jnp.einsum('bhtd,bhsd,bhtsd->bhts', q_, k_, jnp.exp(rel))
        o = (jnp.einsum('bhts,bhsv->bhtv', scores, v_)
             + jnp.einsum('bhtd,bhdv->bhtv', q_ * jnp.exp(bcum), state))
        b_last = bcum[..., -1:, :]
        state = (jnp.exp(b_last[..., 0, :])[..., None] * state
                 + jnp.einsum('bhsd,bhsv->bhdv', k_ * jnp.exp(b_last - bcum), v_))
        return state, o

    _, b, n_h, _, dk = qc.shape
    state0 = jnp.zeros((b, n_h, dk, vc.shape[-1]), qc.dtype)
    _, out = lax.scan(step, state0, (qc, kc, vc, gc))
    return out


def rwkv7_scan(r, w, k, v, kk, a):
    b, _, n_h, n = r.shape

    def step(state, inp):
        rt, wt, kt, vt, kkt, at = inp
        sa = jnp.einsum('bhvk,bhk->bhv', state, -kkt)
        state = (state * wt[:, :, None, :] + sa[..., :, None] * (kkt * at)[:, :, None, :]
                 + vt[..., :, None] * kt[:, :, None, :])
        return state, jnp.einsum('bhvk,bhk->bhv', state, rt)

    xs = tuple(jnp.moveaxis(t, 1, 0) for t in (r, w, k, v, kk, a))
    state0 = jnp.zeros((b, n_h, n, n), r.dtype)
    _, out = lax.scan(step, state0, xs)
    return jnp.moveaxis(out, 0, 1)


def mlstm_chunked(qc, kc, vc, ic, fc):
    mask = causal_mask()

    def step(carry, inp):
        c_mat, n_vec, m = carry
        q_, k_, v_, i_, f_ = inp
        bcum = jnp.cumsum(f_, axis=-1)
        dmat = jnp.where(mask, bcum[..., :, None] - bcum[..., None, :] + i_[..., None, :], -jnp.inf)
        inter = bcum + m[..., None]
        m_t = jnp.maximum(inter, jnp.max(dmat, axis=-1))
        w_inter = jnp.exp(inter - m_t)
        pmat = jnp.exp(dmat - m_t[..., None]) * jnp.einsum('bhtd,bhsd->bhts', q_, k_)
        num = (jnp.einsum('bhts,bhsv->bhtv', pmat, v_)
               + w_inter[..., None] * jnp.einsum('bhtd,bhdv->bhtv', q_, c_mat))
        den = jnp.sum(pmat, axis=-1) + w_inter * jnp.einsum('bhtd,bhd->bht', q_, n_vec)
        h_out = num / jnp.maximum(jnp.abs(den), jnp.exp(-m_t))[..., None]
        b_last = bcum[..., -1]
        src = b_last[..., None] - bcum + i_
        m_new = jnp.maximum(b_last + m, jnp.max(src, axis=-1))
        ws = jnp.exp(src - m_new[..., None])
        carry_decay = jnp.exp(b_last + m - m_new)
        c_mat = carry_decay[..., None, None] * c_mat + jnp.einsum('bhs,bhsd,bhsv->bhdv', ws, k_, v_)
        n_vec = carry_decay[..., None] * n_vec + jnp.einsum('bhs,bhsd->bhd', ws, k_)
        return (c_mat, n_vec, m_new), h_out

    _, b, n_h, _, dqk = qc.shape
    dv = vc.shape[-1]
    init = (jnp.zeros((b, n_h, dqk, dv), qc.dtype), jnp.zeros((b, n_h, dqk), qc.dtype),
            jnp.zeros((b, n_h), qc.dtype))
    _, out = lax.scan(step, init, (qc, kc, vc, ic, fc))
    return out


def ssd_chunked(xc, dtc, dac, bc, cc):
    mask = causal_mask()

    def step(state, inp):
        x_, dt_, da_, b_, c_ = inp
        a = jnp.cumsum(da_, axis=-1)
        seg = jnp.exp(jnp.where(mask, a[..., :, None] - a[..., None, :], -jnp.inf))
        cb = jnp.einsum('bgtn,bgsn->bgts', c_, b_)
        scores = seg * cb[:, :, None] * dt_[..., None, :]
        y = (jnp.einsum('bgrts,bgrsp->bgrtp', scores, x_)
             + jnp.exp(a)[..., None] * jnp.einsum('bgtn,bgrpn->bgrtp', c_, state))
        a_last = a[..., -1:]
        ws = jnp.exp(a_last - a) * dt_
        state = (jnp.exp(a_last)[..., None] * state
                 + jnp.einsum('bgrs,bgrsp,bgsn->bgrpn', ws, x_, b_))
        return state, y

    _, b, g, r, _, p = xc.shape
    state0 = jnp.zeros((b, g, r, p, bc.shape[-1]), xc.dtype)
    _, out = lax.scan(step, state0, (xc, dtc, dac, bc, cc))
    return out


def hgrn2_rwkv7_mixer(u, layer, w_in, w_out, hg_lb_table, hg_norm, rw_mu, rw_w0, rw_w2, rw_a0, rw_a2,
                      rw_g2, rw_k_k, rw_k_a, rw_r_k, rw_ln_w, rw_ln_b):
    f32 = jnp.float32
    b, s, _ = u.shape
    p = (u @ w_in).astype(f32)
    n_hg = sum(HG_COLS)
    p_hg, p_rw = p[..., :n_hg], p[..., n_hg:]

    q, f, i, g = split_cols(p_hg, HG_COLS)
    lb = jnp.cumsum(jax.nn.softmax(hg_lb_table.astype(f32), axis=0), axis=0)
    lb = (lb - lb[0])[layer]
    log_f = jnp.logaddexp(jnp.log(lb), jnp.log1p(-lb) + jax.nn.log_sigmoid(f))
    k = (1.0 - lb) * jax.nn.sigmoid(-f)
    q = jax.nn.silu(q)
    o_hg = hgrn2_chunked(chunk_seq(q.reshape(b, s, HG_HEADS, HG_DK)), chunk_seq(k.reshape(b, s, HG_HEADS, HG_DK)),
                         chunk_seq(i.reshape(b, s, HG_HEADS, HG_DV)), chunk_seq(log_f.reshape(b, s, HG_HEADS, HG_DK)))
    o_hg = head_rmsnorm(unchunk_seq(o_hg), HG_HEADS, hg_norm) * jax.nn.sigmoid(g)

    p_rw = p_rw + (token_shift(p_rw) - p_rw) * rw_mu
    r, k, v, wl, al, gl = split_cols(p_rw, RW_COLS)
    w_log = -jax.nn.softplus(-(rw_w0 + jnp.tanh(wl) @ rw_w2)) - 0.5
    decay = jnp.exp(-jnp.exp(w_log))
    a = jax.nn.sigmoid(rw_a0 + al @ rw_a2)
    gate = jax.nn.sigmoid(gl) @ rw_g2
    heads = lambda t: t.reshape(b, s, RW_HEADS, RW_N)
    kk = heads(k * rw_k_k)
    kk = kk / jnp.maximum(jnp.sqrt(jnp.sum(kk * kk, axis=-1, keepdims=True)), 1e-12)
    k = k * (1.0 + (a - 1.0) * rw_k_a)
    rh, kh, vh = heads(r), heads(k), heads(v)
    o_rw = rwkv7_scan(rh, heads(decay), kh, vh, kk, heads(a))
    o_rw = head_layernorm(o_rw, rw_ln_w, rw_ln_b, RW_GN_EPS)
    bonus = (jnp.sum(rh * kh * rw_r_k, axis=-1, keepdims=True) * vh).reshape(b, s, RW_WIDTH)
    o_rw = (o_rw + bonus) * gate

    return jnp.concatenate([o_hg, o_rw], axis=-1).astype(u.dtype) @ w_out


def mlstm_mamba2_mixer(u, w_in, w_out, ml_i_bias, ml_f_bias, ml_norm, mb_conv_w, mb_conv_b, mb_dt_bias,
                       mb_A_log, mb_D, mb_norm):
    f32 = jnp.float32
    b, s, _ = u.shape
    p = (u @ w_in).astype(f32)
    n_ml = sum(ML_COLS)

    q, k, v, ig, fg, og = split_cols(p[..., :n_ml], ML_COLS)
    softcap = lambda t: ML_GATE_CAP * jnp.tanh(t / ML_GATE_CAP)
    i_pre = softcap(ig + ml_i_bias)
    log_f = jax.nn.log_sigmoid(softcap(fg + ml_f_bias))
    q = q * (ML_DQK ** -0.5)
    o_ml = mlstm_chunked(chunk_seq(q.reshape(b, s, ML_HEADS, ML_DQK)), chunk_seq(k.reshape(b, s, ML_HEADS, ML_DQK)),
                         chunk_seq(v.reshape(b, s, ML_HEADS, ML_DV)), chunk_seq(i_pre, 0), chunk_seq(log_f, 0))
    o_ml = head_rmsnorm(unchunk_seq(o_ml), ML_HEADS, ml_norm) * jax.nn.sigmoid(og)

    z, xbc, dt = split_cols(p[..., n_ml:], MB_COLS)
    xbc = jax.nn.silu(causal_dwconv(xbc, mb_conv_w, mb_conv_b))
    xm, bm, cm = split_cols(xbc, (MB_D_INNER, MB_GROUPS * MB_D_STATE, MB_GROUPS * MB_D_STATE))
    dt = jax.nn.softplus(dt + mb_dt_bias)
    d_a = -jnp.exp(mb_A_log.astype(f32)) * dt
    rep = MB_HEADS // MB_GROUPS
    y = ssd_chunked(chunk_seq(xm.reshape(b, s, MB_GROUPS, rep, MB_HEADDIM)),
                    chunk_seq(dt.reshape(b, s, MB_GROUPS, rep), 0), chunk_seq(d_a.reshape(b, s, MB_GROUPS, rep), 0),
                    chunk_seq(bm.reshape(b, s, MB_GROUPS, MB_D_STATE)), chunk_seq(cm.reshape(b, s, MB_GROUPS, MB_D_STATE)))
    y = unchunk_seq(y) + xm * jnp.repeat(mb_D, MB_HEADDIM)
    y = head_rmsnorm(y * jax.nn.silu(z), MB_GROUPS, mb_norm)

    return jnp.concatenate([o_ml, y], axis=-1).astype(u.dtype) @ w_out


def swiglu(h, w_up, w_down):
    gate, up = jnp.split(h @ w_up, 2, axis=-1)
    return (jax.nn.silu(gate) * up) @ w_down


def setup_inputs(seed: int = 0) -> dict:
    key = jax.random.key(seed)
    keys = iter(jax.random.split(key, 64))
    nrm = lambda shape, scale: scale * jax.random.normal(next(keys), shape, jnp.float32)
    uni = lambda shape, lo, hi: jax.random.uniform(next(keys), shape, jnp.float32, lo, hi)
    ne, no = (DEPTH + 1) // 2, DEPTH // 2
    dt0 = jnp.exp(uni((no, MB_HEADS), float(np.log(1e-3)), float(np.log(1e-1))))
    return {
        'x': nrm((BATCH, SEQ, D_MODEL), 1.0),
        'norm_mix': 1.0 + nrm((DEPTH, D_MODEL), 0.05),
        'norm_ffn': 1.0 + nrm((DEPTH, D_MODEL), 0.05),
        'norm_final': 1.0 + nrm((D_MODEL,), 0.05),
        'w_in_even': nrm((ne, D_MODEL, E_IN_EVEN), D_MODEL ** -0.5),
        'w_out_even': nrm((ne, MIX_WIDTH_EVEN, D_MODEL), 0.5 * MIX_WIDTH_EVEN ** -0.5),
        'hg_lb_table': nrm((DEPTH, HG_HEADS * HG_DK), 0.5),
        'hg_norm': 1.0 + nrm((ne, HG_WIDTH), 0.05),
        'rw_mu': uni((ne, sum(RW_COLS)), 0.0, 1.0),
        'rw_w0': -1.0 + nrm((ne, RW_WIDTH), 0.5),
        'rw_w2': nrm((ne, RW_DECAY_LORA, RW_WIDTH), 0.5 * RW_DECAY_LORA ** -0.5),
        'rw_a0': nrm((ne, RW_WIDTH), 0.1),
        'rw_a2': nrm((ne, RW_AAA_LORA, RW_WIDTH), RW_AAA_LORA ** -0.5),
        'rw_g2': nrm((ne, RW_GATE_LORA, RW_WIDTH), RW_GATE_LORA ** -0.5),
        'rw_k_k': 0.85 + nrm((ne, RW_WIDTH), 0.05),
        'rw_k_a': 1.0 + nrm((ne, RW_WIDTH), 0.05),
        'rw_r_k': nrm((ne, RW_HEADS, RW_N), 0.1),
        'rw_ln_w': 1.0 + nrm((ne, RW_WIDTH), 0.05),
        'rw_ln_b': nrm((ne, RW_WIDTH), 0.02),
        'w_in_odd': nrm((no, D_MODEL, E_IN_ODD), D_MODEL ** -0.5),
        'w_out_odd': nrm((no, MIX_WIDTH_ODD, D_MODEL), 0.5 * MIX_WIDTH_ODD ** -0.5),
        'ml_i_bias': -2.0 + nrm((no, ML_HEADS), 0.5),
        'ml_f_bias': uni((no, ML_HEADS), 3.0, 6.0),
        'ml_norm': 1.0 + nrm((no, ML_HEADS * ML_DV), 0.05),
        'mb_conv_w': nrm((no, MB_CONV, MB_XBC), 0.5 * MB_CONV ** -0.5),
        'mb_conv_b': nrm((no, MB_XBC), 0.02),
        'mb_dt_bias': dt0 + jnp.log(-jnp.expm1(-dt0)),
        'mb_A_log': jnp.log(uni((no, MB_HEADS), 1.0, 16.0)),
        'mb_D': 1.0 + nrm((no, MB_HEADS), 0.1),
        'mb_norm': 1.0 + nrm((no, MB_D_INNER), 0.05),
        'ffn_w_up': nrm((DEPTH, D_MODEL, 2 * D_FF), D_MODEL ** -0.5),
        'ffn_w_down': nrm((DEPTH, D_FF, D_MODEL), 0.5 * D_FF ** -0.5),
    }


def reference(x, norm_mix, norm_ffn, norm_final, w_in_even, w_out_even, hg_lb_table, hg_norm, rw_mu, rw_w0,
              rw_w2, rw_a0, rw_a2, rw_g2, rw_k_k, rw_k_a, rw_r_k, rw_ln_w, rw_ln_b, w_in_odd, w_out_odd,
              ml_i_bias, ml_f_bias, ml_norm, mb_conv_w, mb_conv_b, mb_dt_bias, mb_A_log, mb_D, mb_norm,
              ffn_w_up, ffn_w_down):
    h = x
    for layer in range(DEPTH):
        u = rms_norm(h, norm_mix[layer])
        j = layer // 2
        if layer % 2 == 0:
            m = hgrn2_rwkv7_mixer(u, layer, w_in_even[j], w_out_even[j], hg_lb_table, hg_norm[j], rw_mu[j],
                                  rw_w0[j], rw_w2[j], rw_a0[j], rw_a2[j], rw_g2[j], rw_k_k[j], rw_k_a[j],
                                  rw_r_k[j], rw_ln_w[j], rw_ln_b[j])
        else:
            m = mlstm_mamba2_mixer(u, w_in_odd[j], w_out_odd[j], ml_i_bias[j], ml_f_bias[j], ml_norm[j],
                                   mb_conv_w[j], mb_conv_b[j], mb_dt_bias[j], mb_A_log[j], mb_D[j], mb_norm[j])
        h = h + m.astype(h.dtype)
        h = h + swiglu(rms_norm(h, norm_ffn[layer]), ffn_w_up[layer], ffn_w_down[layer]).astype(h.dtype)
    return rms_norm(h, norm_final)
```

```cpp
#include <hip/hip_runtime.h>
#include <cstdio>
#include <cstdint>

template <int O> __device__ __forceinline__ float xshfl(float v) {
    if constexpr (O < 32) return __builtin_bit_cast(float, __builtin_amdgcn_ds_swizzle(__builtin_bit_cast(int, v), 0x1f | (O << 10)));
    else { int l = (int)__builtin_amdgcn_mbcnt_hi(~0u, __builtin_amdgcn_mbcnt_lo(~0u, 0u)); asm volatile("" : "+v"(l)); return __builtin_bit_cast(float, __builtin_amdgcn_ds_bpermute((l ^ 32) << 2, __builtin_bit_cast(int, v))); }
}
__device__ __forceinline__ float shfl_up_f(float v, int o, int lane_opaque) { return __builtin_bit_cast(float, __builtin_amdgcn_ds_bpermute(((lane_opaque - o) & 63) << 2, __builtin_bit_cast(int, v))); }
__device__ __forceinline__ float readlane_f(float v, int l) { return __builtin_bit_cast(float, __builtin_amdgcn_readlane(__builtin_bit_cast(int, v), l)); }
template <int CTRL> __device__ __forceinline__ float dpp_add(float v) { return v + __builtin_bit_cast(float, __builtin_amdgcn_update_dpp(0, __builtin_bit_cast(int, v), CTRL, 0xf, 0xf, false)); }
__device__ __forceinline__ float row16_sum(float v) { v = dpp_add<0xB1>(v); v = dpp_add<0x4E>(v); v = dpp_add<0x141>(v); v = dpp_add<0x140>(v); return v; }
__device__ __forceinline__ void lds_barrier() { asm volatile("s_waitcnt lgkmcnt(0)\n\ts_barrier" ::: "memory"); }
#define MK_CUTS 1
namespace pg8 {
#define PG8_LAS __attribute__((address_space(3)))
typedef unsigned short bf16_t;
typedef short bf16x8 __attribute__((ext_vector_type(8)));
typedef float f32x4 __attribute__((ext_vector_type(4)));
typedef unsigned u32x4 __attribute__((ext_vector_type(4)));
constexpr int BM = 256, BK = 64, HALF = 128, HTB = HALF * BK * 2  , STAGE_BYTES = 8 * HTB, NXCD = 8, WGM = 8;

__host__ __device__ __forceinline__ int lds_byte(int r, int c) { const int st = (r >> 4) * 2 + (c >> 5), rr = r & 15, cc = c & 31, ob = rr * 64 + cc * 2; return st * 1024 + (ob ^ (((ob >> 9) & 1) << 5)); }
__host__ __device__ __forceinline__ void stage_rc(int b, int& R, int& C) { const int st = b / 1024, sb = b % 1024, swz = sb ^ (((sb >> 9) & 1) << 5); R = (st >> 1) * 16 + swz / 64; C = (st & 1) * 32 + (swz % 64) / 2; }
__host__ __device__ __forceinline__ int perm32(int rho) { const int n = rho >> 4, i = rho & 15; return 8 * (i >> 2) + 4 * n + (i & 3); }

struct Unit { int pm, pn, idx; };
struct Gemm { const bf16_t* A; const bf16_t* Bt; int M, N, K; };

struct StaticOrder {
    int nM, nN, nwg, G, c;
    __host__ __device__ void init(int M, int N, int G_, int c_) { nM = M / BM; nN = N / BM; nwg = nM * nN; G = G_; c = c_; }
    __host__ __device__ bool next(int i, Unit& u) const {
        const long L = (long)i * G + c; if (L >= nwg) return false;
        int wgid = (int)L; { const int q = nwg / NXCD, r = nwg % NXCD, xcd = wgid % NXCD, off = wgid / NXCD; wgid = (xcd < r ? xcd * (q + 1) : r * (q + 1) + (xcd - r) * q) + off; }
        const int nig = WGM * nN, gid = wgid / nig, fm = gid * WGM, gsz = (nM - fm) < WGM ? (nM - fm) : WGM;
        u.pm = fm + ((wgid % nig) % gsz); u.pn = (wgid % nig) / gsz; return true;
    }
    __device__ __forceinline__ void a_ready(const Unit&) const {}
    __device__ __forceinline__ void done(const Unit&) const {}
};

__device__ __forceinline__ unsigned cvt_pk_bf16(float lo, float hi) { unsigned r; asm volatile("v_cvt_pk_bf16_f32 %0, %1, %2" : "=v"(r) : "v"(lo), "v"(hi)); return r; }
typedef float f32x2 __attribute__((ext_vector_type(2)));


__device__ __forceinline__ float row_rstd(const float* ssq, int row, int fq) {
    const f32x4 a = *(const f32x4*)(ssq + (size_t)row * 32 + 8 * fq), b = *(const f32x4*)(ssq + (size_t)row * 32 + 8 * fq + 4);
    float s = ((a[0] + a[1]) + (a[2] + a[3])) + ((b[0] + b[1]) + (b[2] + b[3]));
    s += xshfl<16>(s); s += xshfl<32>(s);
    return 1.0f / sqrtf(s * (1.0f / 2048.0f) + 1e-6f);
}

template <class Sched> __device__ __forceinline__ void rstd_table_fill(PG8_LAS float* rtab, const float* ssq, const Sched& S, int tid_) {
    int tid = tid_; asm volatile("" : "+v"(tid));
    Unit u;
    for (int i = 0; S.next(i, u); ++i) {
        if (tid < 256) { const float* p = ssq + ((size_t)u.pm * 256 + tid) * 32; float s = 0.f;
#pragma unroll
            for (int q = 0; q < 8; ++q) { const f32x4 a = *(const f32x4*)(p + 4 * q); s += (a[0] + a[1]) + (a[2] + a[3]); }
            rtab[i * 256 + tid] = 1.0f / sqrtf(s * (1.0f / 2048.0f) + 1e-6f); }
    }
    __syncthreads();
}
__device__ __forceinline__ float silu_f(float g) { return g * __builtin_amdgcn_rcpf(1.0f + __expf(-g)); }
struct EpiBf16P {
    static constexpr bool PERM = true, AFTER_DRAIN = false;
    bf16_t* O; int ldc; const PG8_LAS float* rtab;
    __device__ __forceinline__ void operator()(const f32x4 (&acc)[2][2][4][2], const Unit& u, int wr, int wc, int fr, int fq) const {
        const int row0 = u.pm * BM + wr * 64 + fr; const int col0 = u.pn * BM + wc * 32 + 8 * fq;
#pragma unroll
        for (int ai = 0; ai < 2; ++ai)
#pragma unroll
            for (int m = 0; m < 4; ++m) { bf16_t* rowp = O + (size_t)(row0 + ai * HALF + m * 16) * ldc + col0;
                const float rs = rtab[u.idx * 256 + wr * 64 + fr + ai * HALF + m * 16];
#pragma unroll
                for (int bj = 0; bj < 2; ++bj) { const f32x4 v0 = acc[ai][bj][m][0] * rs, v1 = acc[ai][bj][m][1] * rs;
                    u32x4 w; w.x = cvt_pk_bf16(v0[0], v0[1]); w.y = cvt_pk_bf16(v0[2], v0[3]); w.z = cvt_pk_bf16(v1[0], v1[1]); w.w = cvt_pk_bf16(v1[2], v1[3]);
                    *(u32x4*)(rowp + bj * HALF) = w; } }
    }
};
struct EpiResF32 {
    static constexpr bool PERM = false, AFTER_DRAIN = false;
    float* C; int ldc;
    __device__ __forceinline__ void operator()(const f32x4 (&acc)[2][2][4][2], const Unit& u, int wr, int wc, int fr, int fq) const {
        const int row0 = u.pm * BM + wr * 64 + fr, col0 = u.pn * BM + wc * 32 + 4 * fq;
#pragma unroll
        for (int ai = 0; ai < 2; ++ai)
#pragma unroll
            for (int m = 0; m < 4; ++m) { float* rowp = C + (size_t)(row0 + ai * HALF + m * 16) * ldc + col0;
#pragma unroll
                for (int bj = 0; bj < 2; ++bj)
#pragma unroll
                    for (int n = 0; n < 2; ++n) { f32x4* p = (f32x4*)(rowp + bj * HALF + n * 16); *p = *p + acc[ai][bj][m][n]; } }
    }
};
struct EpiSwiGLU {
    static constexpr bool PERM = true, AFTER_DRAIN = false;
    bf16_t* O; int ldc; const PG8_LAS float* rtab;
    __device__ __forceinline__ void operator()(const f32x4 (&acc)[2][2][4][2], const Unit& u, int wr, int wc, int fr, int fq) const {
        const int row0 = u.pm * BM + wr * 64 + fr; const int col0 = u.pn * HALF + wc * 32 + 8 * fq;
#pragma unroll
        for (int ai = 0; ai < 2; ++ai)
#pragma unroll
            for (int m = 0; m < 4; ++m) { bf16_t* rowp = O + (size_t)(row0 + ai * HALF + m * 16) * ldc + col0;
                const float rs = rtab[u.idx * 256 + wr * 64 + fr + ai * HALF + m * 16];
                const f32x4 g0 = acc[ai][0][m][0] * rs, g1 = acc[ai][0][m][1] * rs, u0 = acc[ai][1][m][0] * rs, u1 = acc[ai][1][m][1] * rs;
                u32x4 w;
                w.x = cvt_pk_bf16(silu_f(g0[0]) * u0[0], silu_f(g0[1]) * u0[1]); w.y = cvt_pk_bf16(silu_f(g0[2]) * u0[2], silu_f(g0[3]) * u0[3]);
                w.z = cvt_pk_bf16(silu_f(g1[0]) * u1[0], silu_f(g1[1]) * u1[1]); w.w = cvt_pk_bf16(silu_f(g1[2]) * u1[2], silu_f(g1[3]) * u1[3]);
                *(u32x4*)rowp = w; }
    }
};

struct EpiResNorm {
    static constexpr bool PERM = false, AFTER_DRAIN = false;
    float* C; int ldc; bf16_t* Hb; float* ssq_out; const float* Cin;
    __device__ __forceinline__ void operator()(const f32x4 (&acc)[2][2][4][2], const Unit& u, int wr, int wc, int fr, int fq) const {
        const int row0 = u.pm * BM + wr * 64 + fr, col0 = u.pn * BM + wc * 32 + 4 * fq;
#pragma unroll
        for (int ai = 0; ai < 2; ++ai)
#pragma unroll
            for (int m = 0; m < 4; ++m) { const int row = row0 + ai * HALF + m * 16; float* rowp = C + (size_t)row * ldc + col0; const float* rinp = Cin + (size_t)row * ldc + col0; bf16_t* hbp = Hb + (size_t)row * ldc + col0; float s = 0.f;
#pragma unroll
                for (int bj = 0; bj < 2; ++bj)
#pragma unroll
                    for (int n = 0; n < 2; ++n) { f32x4* p = (f32x4*)(rowp + bj * HALF + n * 16); const f32x4 v = *(const f32x4*)(rinp + bj * HALF + n * 16) + acc[ai][bj][m][n]; *p = v;
                        typedef unsigned u32x2 __attribute__((ext_vector_type(2))); u32x2 o; o.x = cvt_pk_bf16(v[0], v[1]); o.y = cvt_pk_bf16(v[2], v[3]); *(u32x2*)(hbp + bj * HALF + n * 16) = o;
                        s += (v[0] * v[0] + v[1] * v[1]) + (v[2] * v[2] + v[3] * v[3]); }
                s += xshfl<16>(s); s += xshfl<32>(s);
                if (fq == 0) ssq_out[(size_t)row * 32 + u.pn * 4 + wc] = s; }
    }
};

struct EpiResBf16 {
    static constexpr bool PERM = true, AFTER_DRAIN = false;
    bf16_t* Hb; int ldc; float* ssq_out;
    __device__ __forceinline__ void operator()(const f32x4 (&acc)[2][2][4][2], const Unit& u, int wr, int wc, int fr, int fq) const {
        const int row0 = u.pm * BM + wr * 64 + fr, col0 = u.pn * BM + wc * 32 + 8 * fq;
#pragma unroll
        for (int ai = 0; ai < 2; ++ai)
#pragma unroll
            for (int m = 0; m < 4; ++m) { const int row = row0 + ai * HALF + m * 16; bf16_t* hbp = Hb + (size_t)row * ldc + col0; float s = 0.f;
#pragma unroll
                for (int bj = 0; bj < 2; ++bj) { const u32x4 o = *(const u32x4*)(hbp + bj * HALF);
                    f32x4 v0 = acc[ai][bj][m][0], v1 = acc[ai][bj][m][1];
                    v0[0] += __builtin_bit_cast(float, o.x << 16); v0[1] += __builtin_bit_cast(float, o.x & 0xffff0000u); v0[2] += __builtin_bit_cast(float, o.y << 16); v0[3] += __builtin_bit_cast(float, o.y & 0xffff0000u);
                    v1[0] += __builtin_bit_cast(float, o.z << 16); v1[1] += __builtin_bit_cast(float, o.z & 0xffff0000u); v1[2] += __builtin_bit_cast(float, o.w << 16); v1[3] += __builtin_bit_cast(float, o.w & 0xffff0000u);
                    s += ((v0[0] * v0[0] + v0[1] * v0[1]) + (v0[2] * v0[2] + v0[3] * v0[3])) + ((v1[0] * v1[0] + v1[1] * v1[1]) + (v1[2] * v1[2] + v1[3] * v1[3]));
                    u32x4 w; w.x = cvt_pk_bf16(v0[0], v0[1]); w.y = cvt_pk_bf16(v0[2], v0[3]); w.z = cvt_pk_bf16(v1[0], v1[1]); w.w = cvt_pk_bf16(v1[2], v1[3]);
                    *(u32x4*)(hbp + bj * HALF) = w; }
                s += xshfl<16>(s); s += xshfl<32>(s);
                if (fq == 0) ssq_out[(size_t)row * 32 + u.pn * 4 + wc] = s; }
    }
};

struct EpiInProj {
    static constexpr bool PERM = true, AFTER_DRAIN = false;
    bf16_t* O; int ldc; const PG8_LAS float* rtab; int hg; const float* lb; _Float16* Hf; bf16_t* Hk;
    __device__ __forceinline__ void operator()(const f32x4 (&acc)[2][2][4][2], const Unit& u, int wr, int wc, int fr, int fq) const {
        const int row0 = u.pm * BM + wr * 64 + fr; const int col0 = u.pn * BM + wc * 32 + 8 * fq;
        const int mode = hg ? (u.pn < 4 ? 1 : (u.pn < 8 ? 2 : 0)) : 0;
        if (mode == 2) {
            const int cf = col0 - 1024;
            f32x4 lbv[2][2];
#pragma unroll
            for (int bj = 0; bj < 2; ++bj) { lbv[bj][0] = *(const f32x4*)(lb + cf + bj * HALF); lbv[bj][1] = *(const f32x4*)(lb + cf + bj * HALF + 4); }
#pragma unroll
            for (int ai = 0; ai < 2; ++ai)
#pragma unroll
                for (int m = 0; m < 4; ++m) { const int row = row0 + ai * HALF + m * 16; const float rs = rtab[u.idx * 256 + wr * 64 + fr + ai * HALF + m * 16];
#pragma unroll
                    for (int bj = 0; bj < 2; ++bj) { f32x4 hf[2], hk[2];
#pragma unroll
                        for (int n = 0; n < 2; ++n)
#pragma unroll
                            for (int j = 0; j < 4; ++j) { const float f = acc[ai][bj][m][n][j] * rs, l = lbv[bj][n][j]; const float ee = __expf(fminf(-f, 80.f)), sg = __builtin_amdgcn_rcpf(1.0f + ee);
                                hf[n][j] = l + (1.f - l) * sg; hk[n][j] = (1.f - l) * ee * sg; }
                        { typedef _Float16 h2 __attribute__((ext_vector_type(2))); u32x4 hw;
                          hw.x = __builtin_bit_cast(unsigned, (h2){(_Float16)hf[0][0], (_Float16)hf[0][1]}); hw.y = __builtin_bit_cast(unsigned, (h2){(_Float16)hf[0][2], (_Float16)hf[0][3]});
                          hw.z = __builtin_bit_cast(unsigned, (h2){(_Float16)hf[1][0], (_Float16)hf[1][1]}); hw.w = __builtin_bit_cast(unsigned, (h2){(_Float16)hf[1][2], (_Float16)hf[1][3]});
                          *(u32x4*)(Hf + (size_t)row * 1024 + cf + bj * HALF) = hw; }
                        u32x4 w; w.x = cvt_pk_bf16(hk[0][0], hk[0][1]); w.y = cvt_pk_bf16(hk[0][2], hk[0][3]); w.z = cvt_pk_bf16(hk[1][0], hk[1][1]); w.w = cvt_pk_bf16(hk[1][2], hk[1][3]);
                        *(u32x4*)(Hk + (size_t)row * 1024 + cf + bj * HALF) = w; } }
            return;
        }
#pragma unroll
        for (int ai = 0; ai < 2; ++ai)
#pragma unroll
            for (int m = 0; m < 4; ++m) { bf16_t* rowp = O + (size_t)(row0 + ai * HALF + m * 16) * ldc + col0;
                const float rs = rtab[u.idx * 256 + wr * 64 + fr + ai * HALF + m * 16];
#pragma unroll
                for (int bj = 0; bj < 2; ++bj) { f32x4 v0 = acc[ai][bj][m][0] * rs, v1 = acc[ai][bj][m][1] * rs;
                    if (mode == 1) {
#pragma unroll
                        for (int j = 0; j < 4; ++j) { v0[j] = silu_f(v0[j]); v1[j] = silu_f(v1[j]); } }
                    u32x4 w; w.x = cvt_pk_bf16(v0[0], v0[1]); w.y = cvt_pk_bf16(v0[2], v0[3]); w.z = cvt_pk_bf16(v1[0], v1[1]); w.w = cvt_pk_bf16(v1[2], v1[3]);
                    *(u32x4*)(rowp + bj * HALF) = w; } }
    }
};
template <class Epi, class Sched, bool ALIGN_EPI = false, bool SP2 = false>
__device__ __forceinline__ void gemm_phase(PG8_LAS unsigned char* lds, const Gemm g, const Sched& S, const Epi& E) {
    int tid_ = threadIdx.x; asm volatile("" : "+v"(tid_));
    const int tid = tid_, wid = __builtin_amdgcn_readfirstlane(tid >> 6), lane = tid & 63, wr = wid >> 2, wc = wid & 3, fr = lane & 15, fq = lane >> 4;
    const int K = g.K, nt = K / BK;
    unsigned voffA[2], voffB[2];
#pragma unroll
    for (int i = 0; i < 2; ++i) { int R, C; stage_rc(tid * 16 + i * 8192, R, C); const int Rb = Epi::PERM ? ((R & ~31) + perm32(R & 31)) : R;
        voffA[i] = (unsigned)(R * K + C) * 2u; voffB[i] = (unsigned)(Rb * K + C) * 2u; }
    const size_t kstep = (size_t)(BK * 2);
    const size_t hstep = (size_t)HALF * K * 2;
    const size_t tstep = 2 * hstep;
    const unsigned ldsw = (unsigned)wid * 1024u;
    const int aoff = lds_byte(wr * 64 + fr, fq * 8), boff = lds_byte(wc * 32 + fr, fq * 8);
#define PG8_SA(b, h) (((b) * 2 + (h)) * HTB)
#define PG8_SB(b, h) ((4 + (b) * 2 + (h)) * HTB)
#define PG8_STAGE(bufoff, gbase, voff) do { _Pragma("unroll") for (int _i = 0; _i < 2; ++_i) \
        __builtin_amdgcn_global_load_lds((const unsigned*)((const char*)(gbase) + (voff)[_i]), (PG8_LAS unsigned*)(lds + (bufoff) + ldsw + _i * 8192), 16, 0, 0); } while (0)
#define PG8_LDA(dst, b, h) do { _Pragma("unroll") for (int m = 0; m < 4; ++m) _Pragma("unroll") for (int k = 0; k < 2; ++k) dst[m][k] = *(const PG8_LAS bf16x8*)(lds + PG8_SA(b, h) + aoff + m * 2048 + k * 1024); } while (0)
#define PG8_LDB(dst, b, h) do { _Pragma("unroll") for (int n = 0; n < 2; ++n) _Pragma("unroll") for (int k = 0; k < 2; ++k) dst[n][k] = *(const PG8_LAS bf16x8*)(lds + PG8_SB(b, h) + boff + n * 2048 + k * 1024); } while (0)
#define PG8_MMA(ai, bj, At, Bt) do { __builtin_amdgcn_s_setprio(1); _Pragma("unroll") for (int m = 0; m < 4; ++m) _Pragma("unroll") for (int n = 0; n < 2; ++n) _Pragma("unroll") for (int k = 0; k < 2; ++k) \
        acc[ai][bj][m][n] = __builtin_amdgcn_mfma_f32_16x16x32_bf16(Bt[n][k], At[m][k], acc[ai][bj][m][n], 0, 0, 0); __builtin_amdgcn_s_setprio(0); } while (0)
#define PG8_WAIT_V(n) asm volatile("s_waitcnt vmcnt(" #n ")" ::: "memory")
#define PG8_WAIT_L(n) asm volatile("s_waitcnt lgkmcnt(" #n ")" ::: "memory")
#define PG8_BAR __builtin_amdgcn_s_barrier()
#define PG8_SCHED __builtin_amdgcn_sched_barrier(0)
    Unit cur, nxt; int ui = 0;
    if (!S.next(0, cur)) return;
    cur.idx = 0;
    f32x4 acc[2][2][4][2];
#pragma unroll
    for (int a = 0; a < 2; ++a)
#pragma unroll
        for (int b = 0; b < 2; ++b)
#pragma unroll
            for (int m = 0; m < 4; ++m)
#pragma unroll
                for (int n = 0; n < 2; ++n) acc[a][b][m][n] = (f32x4){0.f, 0.f, 0.f, 0.f};
    bf16x8 At[4][2], B0[2][2], B1[2][2];
    const char* cA = (const char*)g.A + (size_t)cur.pm * tstep; const char* cB = (const char*)g.Bt + (size_t)cur.pn * tstep;
    S.a_ready(cur);
    if constexpr (SP2) {
        PG8_STAGE(PG8_SB(0, 0), cB, voffB); PG8_STAGE(PG8_SB(0, 1), cB + hstep, voffB); PG8_STAGE(PG8_SA(0, 0), cA, voffA); PG8_STAGE(PG8_SA(0, 1), cA + hstep, voffA);
        if (wr == 1) PG8_BAR;
        PG8_WAIT_V(2); PG8_BAR;
        PG8_STAGE(PG8_SB(1, 0), cB + kstep, voffB); PG8_STAGE(PG8_SA(1, 0), cA + kstep, voffA); PG8_STAGE(PG8_SB(1, 1), cB + hstep + kstep, voffB);
        PG8_WAIT_V(6); PG8_BAR;
    } else {
        PG8_STAGE(PG8_SB(0, 0), cB, voffB); PG8_STAGE(PG8_SA(0, 0), cA, voffA); PG8_STAGE(PG8_SB(0, 1), cB + hstep, voffB); PG8_STAGE(PG8_SA(0, 1), cA + hstep, voffA);
        if (wr == 1) PG8_BAR;
        PG8_WAIT_V(4); PG8_BAR;
        PG8_STAGE(PG8_SB(1, 0), cB + kstep, voffB); PG8_STAGE(PG8_SA(1, 0), cA + kstep, voffA); PG8_STAGE(PG8_SB(1, 1), cB + hstep + kstep, voffB);
        PG8_WAIT_V(6); PG8_BAR;
    }
    for (;;) {
        const bool has_next = S.next(ui + 1, nxt); nxt.idx = ui + 1;
        const char* nA = has_next ? (const char*)g.A + (size_t)nxt.pm * tstep : cA; const char* nB = has_next ? (const char*)g.Bt + (size_t)nxt.pn * tstep : cB;
        for (int t = 0; t < nt; t += 2) {
            const bool last = (t == nt - 2);
            const char* a1 = cA + (size_t)(t + 1) * kstep;
            const char* a2 = last ? nA : cA + (size_t)(t + 2) * kstep; const char* b2 = last ? nB : cB + (size_t)(t + 2) * kstep;
            const char* a3 = a2 + kstep; const char* b3 = b2 + kstep;
            if (last && has_next) S.a_ready(nxt);
            if constexpr (SP2) {
            PG8_LDB(B0, 0, 0); PG8_LDB(B1, 0, 1); PG8_SCHED; PG8_LDA(At, 0, 0); PG8_STAGE(PG8_SA(1, 1), a1 + hstep, voffA);
            PG8_WAIT_V(8); PG8_WAIT_L(0); PG8_BAR; PG8_MMA(0, 0, At, B0); PG8_MMA(0, 1, At, B1); PG8_BAR; PG8_SCHED;
            PG8_LDA(At, 0, 1); PG8_STAGE(PG8_SB(0, 0), b2, voffB); PG8_STAGE(PG8_SB(0, 1), b2 + hstep, voffB); PG8_STAGE(PG8_SA(0, 0), a2, voffA);
            PG8_WAIT_V(8); PG8_WAIT_L(0); PG8_BAR; PG8_MMA(1, 0, At, B0); PG8_MMA(1, 1, At, B1); PG8_BAR; PG8_SCHED;
            PG8_LDB(B0, 1, 0); PG8_LDB(B1, 1, 1); PG8_SCHED; PG8_LDA(At, 1, 0); PG8_STAGE(PG8_SA(0, 1), a2 + hstep, voffA);
            PG8_WAIT_V(8); PG8_WAIT_L(0); PG8_BAR; PG8_MMA(0, 0, At, B0); PG8_MMA(0, 1, At, B1); PG8_BAR; PG8_SCHED;
            PG8_LDA(At, 1, 1); PG8_STAGE(PG8_SB(1, 0), b3, voffB); PG8_STAGE(PG8_SB(1, 1), b3 + hstep, voffB); PG8_STAGE(PG8_SA(1, 0), a3, voffA);
            PG8_WAIT_V(8); PG8_WAIT_L(0); PG8_BAR; PG8_MMA(1, 0, At, B0); PG8_MMA(1, 1, At, B1); PG8_BAR; PG8_SCHED;
            } else {
            PG8_LDB(B0, 0, 0); PG8_SCHED; PG8_LDA(At, 0, 0); PG8_STAGE(PG8_SA(1, 1), a1 + hstep, voffA);
            PG8_WAIT_L(8); PG8_BAR; PG8_WAIT_L(0); PG8_MMA(0, 0, At, B0); PG8_BAR; PG8_SCHED;
            PG8_LDB(B1, 0, 1); PG8_STAGE(PG8_SB(0, 0), b2, voffB);
            PG8_BAR; PG8_WAIT_L(0); PG8_MMA(0, 1, At, B1); PG8_BAR;
            PG8_LDA(At, 0, 1); PG8_STAGE(PG8_SA(0, 0), a2, voffA);
            PG8_BAR; PG8_WAIT_L(0); PG8_MMA(1, 0, At, B0); PG8_BAR; PG8_SCHED;
            PG8_STAGE(PG8_SB(0, 1), b2 + hstep, voffB);
            PG8_WAIT_V(6); PG8_BAR; PG8_MMA(1, 1, At, B1); PG8_BAR;
            PG8_LDB(B0, 1, 0); PG8_SCHED; PG8_LDA(At, 1, 0); PG8_STAGE(PG8_SA(0, 1), a2 + hstep, voffA);
            PG8_WAIT_L(8); PG8_BAR; PG8_WAIT_L(0); PG8_MMA(0, 0, At, B0); PG8_BAR; PG8_SCHED;
            PG8_LDB(B1, 1, 1); PG8_STAGE(PG8_SB(1, 0), b3, voffB);
            PG8_BAR; PG8_WAIT_L(0); PG8_MMA(0, 1, At, B1); PG8_BAR;
            PG8_LDA(At, 1, 1); PG8_STAGE(PG8_SA(1, 0), a3, voffA);
            PG8_BAR; PG8_WAIT_L(0); PG8_MMA(1, 0, At, B0); PG8_BAR; PG8_SCHED;
            PG8_STAGE(PG8_SB(1, 1), b3 + hstep, voffB);
            PG8_WAIT_V(6); PG8_BAR; PG8_MMA(1, 1, At, B1); PG8_BAR;
            }
        }
        if constexpr (ALIGN_EPI) { if (wr == 0) PG8_BAR; }
        if constexpr (!Epi::AFTER_DRAIN) { E(acc, cur, wr, wc, fr, fq); S.done(cur); }
        if (!has_next) break;
#pragma unroll
        for (int a = 0; a < 2; ++a)
#pragma unroll
            for (int b = 0; b < 2; ++b)
#pragma unroll
                for (int m = 0; m < 4; ++m)
#pragma unroll
                    for (int n = 0; n < 2; ++n) acc[a][b][m][n] = (f32x4){0.f, 0.f, 0.f, 0.f};
        cur = nxt; cA = nA; cB = nB; ++ui;
        if constexpr (ALIGN_EPI) { if (wr == 1) PG8_BAR; }
    }
    PG8_WAIT_V(0);
    if constexpr (!ALIGN_EPI) { if (wr == 0) PG8_BAR; }
    PG8_BAR;
    if constexpr (Epi::AFTER_DRAIN) { E.fused(acc, cur, wr, wc, fr, fq, lds, wid, lane); S.done(cur); }
#undef PG8_SA
#undef PG8_SB
#undef PG8_STAGE
#undef PG8_LDA
#undef PG8_LDB
#undef PG8_MMA
#undef PG8_WAIT_V
#undef PG8_WAIT_L
#undef PG8_BAR
#undef PG8_SCHED
}
}

constexpr int SEQ = 8192, DM = 2048, DEPTH = 4, DFF = 5632;
constexpr int E_EVEN = 7456, E_EVEN_PAD = 7680, E_ODD = 5656, E_ODD_PAD = 5888, LDP = 7680;
constexpr float EPS = 1e-6f;
constexpr int NWAVES = 8, NTHREADS = 512;
constexpr int HGC_Q = 0, HGC_F = 1024, HGC_I = 2048, HGC_G = 3072, RWC_R = 4096, RWC_K = 5120, RWC_V = 6144, RWC_WL = 7168, RWC_AL = 7232, RWC_GL = 7296;
constexpr int MLC_Q = 0, MLC_K = 512, MLC_V = 1024, MLC_I = 2048, MLC_F = 2052, MLC_O = 2056, MBC_Z = 3080, MBC_X = 4104, MBC_DT = 5640;

constexpr size_t MiB = 1u << 20;
constexpr size_t WS_CTL = 0, CTL_ZERO_BYTES = 1 * MiB;
constexpr size_t WS_WINE = 2 * MiB, WS_WOUTE = 62 * MiB, WS_WINO = 78 * MiB, WS_WOUTO = 124 * MiB, WS_WUP = 140 * MiB, WS_WDN = 316 * MiB;
constexpr size_t WS_XN = 404 * MiB, WS_P = 436 * MiB, WS_MIX = 556 * MiB, WS_ACT = 588 * MiB, WS_SCR = 676 * MiB, SCR_SLOT = 32 * MiB, WS_LORA = WS_SCR + 22 * SCR_SLOT, WS_SSQ = WS_LORA + 2 * MiB, WS_LB = WS_SSQ + 9 * MiB, WS_END = WS_LB + 1 * MiB;
constexpr size_t LORA_LAYER = 1024 * 64 + 1024 * 64 + 1024 * 160, LORA_A2 = 1024 * 64, LORA_G2 = 2 * 1024 * 64;
static_assert(WS_WINE + (size_t)2 * E_EVEN_PAD * DM * 2 <= WS_WOUTE && WS_WINO + (size_t)2 * E_ODD_PAD * DM * 2 <= WS_WOUTO && WS_WUP + (size_t)4 * 2 * DFF * DM * 2 <= WS_WDN && WS_WDN + (size_t)4 * DM * DFF * 2 <= WS_XN, "ws map (weights)");
static_assert(WS_P + (size_t)SEQ * LDP * 2 <= WS_MIX && WS_ACT + (size_t)SEQ * DFF * 2 <= WS_SCR, "ws map (activations)");
constexpr int CW_BAR = 4096;
constexpr size_t CTL_SSQ_UNUSED = 65536;

constexpr int RING_OFF = 0, RING_BYTES = 131072;
constexpr int LDSCTL_OFF = RING_BYTES, MISC_OFF = LDSCTL_OFF + 320;
constexpr int RTAB_OFF = LDSCTL_OFF + 1024;
constexpr int LDS_BYTES = 147456;

#define GAS __attribute__((address_space(1)))
#define LAS __attribute__((address_space(3)))
typedef unsigned short bf16;
typedef unsigned v4u __attribute__((ext_vector_type(4)));
typedef unsigned v2u __attribute__((ext_vector_type(2)));
typedef float f32x4 __attribute__((ext_vector_type(4)));
typedef GAS unsigned gu32;
#define RLX_AGENT __ATOMIC_RELAXED, __HIP_MEMORY_SCOPE_AGENT
#define OPAQUE_V(x) asm volatile("" : "+v"(x))
#define LDS_WAIT() asm volatile("s_waitcnt lgkmcnt(0)" ::: "memory")
#define VM_WAIT() asm volatile("s_waitcnt vmcnt(0)" ::: "memory")
typedef __bf16 hwbf16x2 __attribute__((ext_vector_type(2)));
__device__ __forceinline__ unsigned pk2(float lo, float hi) { hwbf16x2 v; v.x = (__bf16)lo; v.y = (__bf16)hi; return __builtin_bit_cast(unsigned, v); }
__device__ __forceinline__ unsigned f2bf(float f) { return (unsigned)__builtin_bit_cast(unsigned short, (__bf16)f); }
__device__ __forceinline__ float bf2f(bf16 b) { return __builtin_bit_cast(float, ((unsigned)b) << 16); }
__device__ __forceinline__ float sigmoid_f(float x) { return __builtin_amdgcn_rcpf(1.0f + __expf(-x)); }
__device__ __forceinline__ float silu_acc(float x) { return x * __builtin_amdgcn_rcpf(1.0f + __expf(-x)); }
__device__ __forceinline__ float softplus_f(float x) { return x > 20.f ? x : __logf(1.0f + __expf(x)); }
__device__ __forceinline__ float softplus_acc(float x) { if (x > 20.f) return x; const float e = __expf(x); return e < 0.02f ? e * (1.0f - e * (0.5f - e * (0.33333334f - e * 0.25f))) : __logf(1.0f + e); }
__device__ __forceinline__ float tanh_f(float x) { const float e = __expf(2.0f * fminf(fmaxf(x, -15.f), 15.f)); return (e - 1.0f) * __builtin_amdgcn_rcpf(e + 1.0f); }
__device__ __forceinline__ float wave_sum(float v) {
    v = row16_sum(v); v += xshfl<16>(v); v += xshfl<32>(v);
    return v;
}

#define XB_TMO      128
#define XB_XCNT(j)  (256  + 64 * (j))
#define XB_XSUB(j)  (1280 + 64 * (j))
#define XB_XGEN(j)  (2304 + 64 * (j))
#define XB_TOP      3328
#define XB_TOPGEN   3392
#define XCD_BAR_WORDS 3456
#define XB_SPIN_CAP (1u << 18)

__device__ __forceinline__ unsigned xb_ld(unsigned* p)              { return __hip_atomic_load(p, __ATOMIC_RELAXED, __HIP_MEMORY_SCOPE_AGENT); }
__device__ __forceinline__ unsigned xb_add(unsigned* p, unsigned v) { return __hip_atomic_fetch_add(p, v, __ATOMIC_RELAXED, __HIP_MEMORY_SCOPE_AGENT); }
__device__ __forceinline__ unsigned xb_xcc_id() { return (unsigned)__builtin_amdgcn_s_getreg((3 << 11) | 20) & 0xFu; }
#define XB_SPIN(cond, bar) do { unsigned _sp = 0; while (cond) { __builtin_amdgcn_s_sleep(1); \
    if ((++_sp & 255u) == 0u) { if (xb_ld(&(bar)[XB_TMO])) break; if (_sp > XB_SPIN_CAP) { atomicAdd(&(bar)[XB_TMO], 1u); break; } } } } while (0)

struct XcdBarrier {
    unsigned* bar; unsigned x;
    volatile LAS unsigned* st;
};
__device__ __forceinline__ XcdBarrier xcd_barrier_post(unsigned* bar, volatile LAS unsigned* st) {
    XcdBarrier b; b.bar = bar; b.x = xb_xcc_id(); b.st = st;
    if (threadIdx.x == 0) (void)xb_add(&bar[XB_XCNT(b.x)], 1u);
    return b;
}
__device__ __forceinline__ void xcd_barrier_complete(unsigned* bar, unsigned x, unsigned& nloc, unsigned& nx) {
    const unsigned G = gridDim.x * gridDim.y * gridDim.z;
    unsigned sum, cnt, mine, sp = 0u;
    for (;;) {
        sum = 0u; cnt = 0u; mine = 0u;
#pragma unroll
        for (unsigned j = 0; j < 16; ++j) { const unsigned c = xb_ld(&bar[XB_XCNT(j)]); sum += c; cnt += (c > 0u) ? 1u : 0u; mine = (j == x) ? c : mine; }
        if (sum == G) break;
        __builtin_amdgcn_s_sleep(1);
        if ((++sp & 255u) == 0u) { if (xb_ld(&bar[XB_TMO])) break; if (sp > XB_SPIN_CAP) { atomicAdd(&bar[XB_TMO], 1u); break; } }
    }
    nloc = mine > 0u ? mine : 1u; nx = cnt > 0u ? cnt : 1u;
}
__device__ __forceinline__ void xcd_barrier(const XcdBarrier& b) {
    asm volatile("s_waitcnt vmcnt(0)" ::: "memory");
    __syncthreads();
    if (threadIdx.x == 0) {
        unsigned* bar = b.bar;
        __builtin_amdgcn_s_waitcnt(0);
        unsigned nloc = b.st[0], nx = b.st[1];
        if (nloc == 0u) { xcd_barrier_complete(bar, b.x, nloc, nx); b.st[0] = nloc; b.st[1] = nx; }
        const unsigned old = xb_add(&bar[XB_XSUB(b.x)], 1u);
        const unsigned gen = old / nloc;
        if (old + 1u == (gen + 1u) * nloc) {
            __builtin_amdgcn_fence(__ATOMIC_RELEASE, "agent");
            asm volatile("s_waitcnt vmcnt(0)" ::: "memory");
            const unsigned og = xb_add(&bar[XB_TOP], 1u);
            const unsigned tg = og / nx;
            if (og + 1u == (tg + 1u) * nx) xb_add(&bar[XB_TOPGEN], 1u);
            else XB_SPIN(xb_ld(&bar[XB_TOPGEN]) == tg, bar);
            __builtin_amdgcn_fence(__ATOMIC_ACQUIRE, "agent");
            xb_add(&bar[XB_XGEN(b.x)], 1u);
            asm volatile("s_waitcnt vmcnt(0)" ::: "memory");
        } else {
            XB_SPIN(xb_ld(&bar[XB_XGEN(b.x)]) == gen, bar);
            __builtin_amdgcn_fence(__ATOMIC_ACQUIRE, "agent");
            asm volatile("s_waitcnt vmcnt(0)" ::: "memory");
        }
    }
    __syncthreads();
}

struct Args { const float* in[32]; float* out; unsigned char* ws; int ph_lo, ph_hi, li, pad; };
struct Frame {
    LAS unsigned char* lds;
    volatile LAS unsigned* MISC;
    gu32* ctl;
    int tid, lane, wave, G, bid;
    float* h;
    unsigned char* ws;
};
#define F_IN(i) (args.in[i])
__device__ __forceinline__ bf16* ws_bf(Frame& F, size_t off) { return (bf16*)(F.ws + off); }
__device__ __forceinline__ float* ssq_f(Frame& F, int s) { return (float*)(F.ws + WS_SSQ + (size_t)s * MiB); }
__device__ __forceinline__ float* scr_f(Frame& F, int slot) { return (float*)(F.ws + WS_SCR + (size_t)slot * SCR_SLOT); }

struct CvtDesc { const float* W; bf16* dst; const float* gain; int K, N, mode, k0, n0; bool valid; };
constexpr int CVT_PITCH = 1040;
__device__ __forceinline__ void cvt_decode(Frame& F, const Args& args, int layer, int it, CvtDesc& d) {
    const int jh = layer >> 1; const bool od = (layer & 1) != 0;
    const int npad_in = od ? E_ODD_PAD : E_EVEN_PAD;
    const int n_in = (DM / 512) * (npad_in / 64), n_out = (DM / 512) * (DM / 64), n_up = (DM / 512) * (2 * DFF / 64), n_dn = (DFF / 512) * (DM / 64);
    d.valid = it < n_in + n_out + n_up + n_dn; d.mode = 0; d.gain = nullptr; int nblk;
    if (it < n_in) { d.K = DM; d.N = od ? E_ODD : E_EVEN; nblk = npad_in / 64; d.gain = F_IN(1) + (size_t)layer * DM;
        d.W = od ? F_IN(19) + (size_t)jh * DM * E_ODD : F_IN(4) + (size_t)jh * DM * E_EVEN; d.dst = od ? ws_bf(F, WS_WINO) + (size_t)jh * E_ODD_PAD * DM : ws_bf(F, WS_WINE) + (size_t)jh * E_EVEN_PAD * DM; }
    else if (it < n_in + n_out) { it -= n_in; d.K = DM; d.N = DM; nblk = DM / 64;
        d.W = (od ? F_IN(20) : F_IN(5)) + (size_t)jh * DM * DM; d.dst = ws_bf(F, od ? WS_WOUTO : WS_WOUTE) + (size_t)jh * DM * DM; }
    else if (it < n_in + n_out + n_up) { it -= n_in + n_out; d.K = DM; d.N = 2 * DFF; nblk = 2 * DFF / 64; d.mode = 1; d.gain = F_IN(2) + (size_t)layer * DM;
        d.W = F_IN(30) + (size_t)layer * DM * 2 * DFF; d.dst = ws_bf(F, WS_WUP) + (size_t)layer * 2 * DFF * DM; }
    else { it -= n_in + n_out + n_up; d.K = DFF; d.N = DM; nblk = DM / 64;
        d.W = F_IN(31) + (size_t)layer * DFF * DM; d.dst = ws_bf(F, WS_WDN) + (size_t)layer * DM * DFF; }
    d.n0 = 64 * (it % nblk); d.k0 = 512 * (it / nblk);
}
__device__ __forceinline__ void cvt_load(const CvtDesc& d, int wave, int lane, f32x4 (&v)[16]) {
    const int nn = d.n0 + 4 * (lane & 15); const bool ok = nn < d.N;
#pragma unroll
    for (int i = 0; i < 16; ++i) { const int kk = d.k0 + 64 * wave + 4 * i + (lane >> 4); v[i] = ok ? *(const GAS f32x4*)(d.W + (size_t)kk * d.N + nn) : (f32x4){0.f, 0.f, 0.f, 0.f}; }
}
__device__ __forceinline__ void cvt_put(const CvtDesc& d, int wave, int lane, const f32x4 (&v)[16], LAS unsigned char* tile) {
    const int nq = 4 * (lane & 15);
#pragma unroll
    for (int i = 0; i < 16; ++i) { const int kk = 4 * i + (lane >> 4); const float gk = d.gain ? d.gain[d.k0 + 64 * wave + kk] : 1.0f;
#pragma unroll
        for (int e = 0; e < 4; ++e) *(LAS bf16*)(tile + (nq + e) * CVT_PITCH + wave * 128 + (((kk >> 3) ^ ((nq >> 2) & 7)) * 16) + (kk & 7) * 2) = (bf16)f2bf(v[i][e] * gk); }
}
__device__ __forceinline__ void cvt_write(const CvtDesc& d, int wave, int lane, const LAS unsigned char* tile) {
    int r0 = d.n0;
    if (d.mode == 1) { r0 = (d.n0 < DFF) ? ((d.n0 >> 7) * 256 + (d.n0 & 127)) : (((d.n0 - DFF) >> 7) * 256 + 128 + ((d.n0 - DFF) & 127)); }
#pragma unroll
    for (int i = 0; i < 8; ++i) { const int n = 8 * wave + i;
        *(GAS v4u*)(d.dst + (size_t)(r0 + n) * d.K + d.k0 + lane * 8) = *(const LAS v4u*)(tile + n * CVT_PITCH + (lane >> 3) * 128 + (((lane & 7) ^ ((n >> 2) & 7)) * 16)); }
}
constexpr int CW_CVTQ = 2048;
constexpr int CLAIM_OFF = LDSCTL_OFF + 512;
constexpr int CVT_N_OUT = (DM / 512) * (DM / 64), CVT_N_UP = (DM / 512) * (2 * DFF / 64), CVT_N_DN = (DFF / 512) * (DM / 64);
constexpr int CVT_N_INE = (DM / 512) * (E_EVEN_PAD / 64), CVT_N_INO = (DM / 512) * (E_ODD_PAD / 64);
constexpr int CVT_EVEN = CVT_N_INE + CVT_N_OUT + CVT_N_UP + CVT_N_DN, CVT_ODD = CVT_N_INO + CVT_N_OUT + CVT_N_UP + CVT_N_DN, CVT_TOTAL = 2 * (CVT_EVEN + CVT_ODD);
__host__ __device__ constexpr int cvt_off(int L) { return (L >> 1) * (CVT_EVEN + CVT_ODD) + (L & 1) * CVT_EVEN; }
__host__ __device__ constexpr int cvt_mark(int L, int which) { return cvt_off(L) + ((L & 1) ? CVT_N_INO : CVT_N_INE) + (which >= 1 ? CVT_N_OUT : 0) + (which >= 2 ? CVT_N_UP : 0) + (which >= 3 ? CVT_N_DN : 0); }
__device__ __forceinline__ void cvt_until(Frame& F, const Args& args, int limit, int budget) {
    LAS unsigned char* tile = F.lds + RING_OFF; LAS int* slot = (LAS int*)(F.lds + CLAIM_OFF);
    unsigned* q = (unsigned*)(F.ctl + CW_CVTQ);
    const int wave = F.wave; int lane = F.lane; OPAQUE_V(lane);
    for (int n = 0; n < budget; ++n) {
        __syncthreads();
        if (F.tid == 0) { unsigned g = __hip_atomic_load(q, __ATOMIC_RELAXED, __HIP_MEMORY_SCOPE_AGENT); int r = -1;
            if ((int)g < limit) { g = __hip_atomic_fetch_add(q, 1u, __ATOMIC_RELAXED, __HIP_MEMORY_SCOPE_AGENT); if ((int)g < CVT_TOTAL) r = (int)g; }
            *slot = r; }
        __syncthreads();
        const int g = *slot; if (g < 0) break;
        const int layer = g >= cvt_off(3) ? 3 : (g >= cvt_off(2) ? 2 : (g >= cvt_off(1) ? 1 : 0));
        CvtDesc d; cvt_decode(F, args, layer, g - cvt_off(layer), d); f32x4 v[16];
        cvt_load(d, wave, lane, v); cvt_put(d, wave, lane, v, tile);
        __syncthreads();
        cvt_write(d, wave, lane, tile);
    }
    __syncthreads();
}
__device__ __forceinline__ void probe_read_weights(Frame& F, const Args& args, int layer) {
    const int gw = F.bid, NGW = F.G; int lane = F.lane; OPAQUE_V(lane);
    CvtDesc d; f32x4 v[16]; float s = 0.f;
    for (int j = gw; ; j += NGW) { cvt_decode(F, args, layer, j, d); if (!d.valid) break; cvt_load(d, F.wave, lane, v);
#pragma unroll
        for (int i = 0; i < 16; ++i) s += (v[i][0] + v[i][1]) + (v[i][2] + v[i][3]); }
    if (s == 123.456f) scr_f(F, 21)[2000000 + gw] = s;
}
__device__ __forceinline__ void phase_convert_lora(Frame& F, const Args& args) {
    const int gw = F.bid * NWAVES + F.wave, NGW = F.G * NWAVES; int lane = F.lane; OPAQUE_V(lane);
    if (F.bid == 0) { float* lbt = (float*)(F.ws + WS_LB); const float* tab = F_IN(6);
        for (int c = F.tid; c < 1024; c += NTHREADS) { const float t0 = tab[c], t1 = tab[1024 + c], t2 = tab[2048 + c], t3 = tab[3072 + c]; const float mx = fmaxf(fmaxf(t0, t1), fmaxf(t2, t3));
            const float e0 = __expf(t0 - mx), e1 = __expf(t1 - mx), e2 = __expf(t2 - mx), e3 = __expf(t3 - mx), inv = __builtin_amdgcn_rcpf(e0 + e1 + e2 + e3);
            lbt[c] = 0.f; lbt[1024 + c] = e1 * inv; lbt[2048 + c] = (e1 + e2) * inv; lbt[3072 + c] = (e1 + e2 + e3) * inv; } }
    { bf16* lo = ws_bf(F, WS_LORA);
      for (int e = gw * 64 + lane; e < 2 * (int)LORA_LAYER; e += NGW * 64) { const int jl = e >= (int)LORA_LAYER, r = e - jl * (int)LORA_LAYER; float v;
          if (r < (int)LORA_A2) { const int c = r >> 6, jj = r & 63; v = F_IN(10)[(size_t)jl * 64 * 1024 + jj * 1024 + c]; }
          else if (r < (int)LORA_G2) { const int q = r - (int)LORA_A2, c = q >> 6, jj = q & 63; v = F_IN(12)[(size_t)jl * 64 * 1024 + jj * 1024 + c]; }
          else { const int q = r - (int)LORA_G2, c = q / 160, jj = q % 160; v = F_IN(13)[(size_t)jl * 160 * 1024 + jj * 1024 + c]; }
          lo[e] = (bf16)f2bf(v); } }
}

__device__ __forceinline__ void phase_x_init(Frame& F, const float* x, bf16* hb, float* ssq) {
    const int gw = F.bid * NWAVES + F.wave, NGW = F.G * NWAVES; int lane = F.lane; OPAQUE_V(lane);
    for (int m = gw; m < SEQ; m += NGW) {
        const GAS f32x4* xr = (const GAS f32x4*)(x + (size_t)m * DM) + lane;
        f32x4 v[8]; float s = 0.f;
#pragma unroll
        for (int j = 0; j < 8; ++j) { v[j] = xr[64 * j]; s += (v[j].x * v[j].x + v[j].y * v[j].y) + (v[j].z * v[j].z + v[j].w * v[j].w); }
        s = wave_sum(s); if (lane < 32) ssq[(size_t)m * 32 + lane] = lane == 0 ? s : 0.f;
        GAS v2u* o8 = (GAS v2u*)(hb + (size_t)m * DM) + lane;
#pragma unroll
        for (int j = 0; j < 8; ++j) { v2u o; o.x = pk2(v[j].x, v[j].y); o.y = pk2(v[j].z, v[j].w); o8[64 * j] = o; }
    }
}
__device__ __forceinline__ void phase_final_norm(Frame& F, const float* gain, const float* ssq, const bf16* hb) {
    const int gw = F.bid * NWAVES + F.wave, NGW = F.G * NWAVES; int lane = F.lane; OPAQUE_V(lane);
    for (int m = gw; m < SEQ; m += NGW) {
        const float rstd = 1.0f / sqrtf(wave_sum(lane < 32 ? ssq[(size_t)m * 32 + lane] : 0.f) * (1.f / DM) + EPS);
#pragma unroll
        for (int j = 0; j < 4; ++j) { const int c0 = (lane + 64 * j) * 8; const v4u o = *(const v4u*)(hb + (size_t)m * DM + c0);
            const f32x4 g0 = *(const f32x4*)(gain + c0), g1 = *(const f32x4*)(gain + c0 + 4);
            const f32x4 a = (f32x4){__builtin_bit_cast(float, o.x << 16) * rstd * g0[0], __builtin_bit_cast(float, o.x & 0xffff0000u) * rstd * g0[1], __builtin_bit_cast(float, o.y << 16) * rstd * g0[2], __builtin_bit_cast(float, o.y & 0xffff0000u) * rstd * g0[3]};
            const f32x4 b = (f32x4){__builtin_bit_cast(float, o.z << 16) * rstd * g1[0], __builtin_bit_cast(float, o.z & 0xffff0000u) * rstd * g1[1], __builtin_bit_cast(float, o.w << 16) * rstd * g1[2], __builtin_bit_cast(float, o.w & 0xffff0000u) * rstd * g1[3]};
            *(f32x4*)(F.h + (size_t)m * DM + c0) = a; *(f32x4*)(F.h + (size_t)m * DM + c0 + 4) = b; }
    }
}

constexpr int S_HQ = 0, S_HF = 1, S_HK = 2, S_HO = 3, S_RR = 4, S_RW = 5, S_RK2 = 6, S_RKK = 7, S_RKKA = 8, S_RV = 9, S_RGATE = 10, S_RBONUS = 11, S_RO = 12;
constexpr int S_MQ = 0, S_MK = 1, S_MNUM = 2, S_SMALL = 3, S_BX = 4, S_BB = 5, S_BC = 6, S_BY = 7;
constexpr size_t SM_EM_POST = 3 * MiB / 4;
constexpr size_t SM_EI = 0, SM_F = 1 * MiB / 4, SM_DEN = 2 * MiB / 4, SM_DT = 4 * MiB / 4, SM_DA = 8 * MiB / 4;

__device__ __forceinline__ void phase_even_pre(Frame& F, const Args& args, int layer) {
    const int j = layer >> 1; int tid = F.tid; OPAQUE_V(tid);
    const bf16* P = ws_bf(F, WS_P);
    LAS float* lbv = (LAS float*)(F.lds);
    LAS float* lin = (LAS float*)(F.lds + 4096);
    const float* tab = F_IN(6);
    for (int c = tid; c < 1024; c += NTHREADS) {
        const float t0 = tab[c], t1 = tab[1024 + c], t2 = tab[2048 + c], t3 = tab[3072 + c];
        const float mx = fmaxf(fmaxf(t0, t1), fmaxf(t2, t3));
        const float e0 = expf(t0 - mx), e1 = expf(t1 - mx), e2 = expf(t2 - mx), e3 = expf(t3 - mx), inv = 1.0f / (e0 + e1 + e2 + e3);
        float lb = 0.f; if (layer >= 1) lb += e1 * inv; if (layer >= 2) lb += e2 * inv; if (layer >= 3) lb += e3 * inv;
        lbv[c] = lb;
    }
    __syncthreads();
    const float* mu = F_IN(8) + (size_t)j * 3360; const float* w0 = F_IN(9) + j * 1024; const float* w2 = F_IN(10) + (size_t)j * 64 * 1024;
    const float* a0 = F_IN(11) + j * 1024; const float* a2 = F_IN(12) + (size_t)j * 64 * 1024; const float* g2 = F_IN(13) + (size_t)j * 160 * 1024;
    const float* k_k = F_IN(14) + j * 1024; const float* k_a = F_IN(15) + j * 1024; const float* r_k = F_IN(16) + j * 1024;
    float* Hq = scr_f(F, S_HQ); float* Hf = scr_f(F, S_HF); float* Hk = scr_f(F, S_HK);
    float* Rr = scr_f(F, S_RR); float* Rw = scr_f(F, S_RW); float* Rk2 = scr_f(F, S_RK2); float* Rkk = scr_f(F, S_RKK); float* Rkka = scr_f(F, S_RKKA);
    float* Rv = scr_f(F, S_RV); float* Rgate = scr_f(F, S_RGATE); float* Rbonus = scr_f(F, S_RBONUS);
    for (int t = F.bid; t < SEQ; t += F.G) {
        const bf16* pr = P + (size_t)t * LDP; const bf16* pp = pr - LDP; const bool hasp = t > 0;
#pragma unroll
        for (int cc = 0; cc < 2; ++cc) { const int c = tid + 512 * cc;
            const float q = bf2f(pr[HGC_Q + c]), f = bf2f(pr[HGC_F + c]), lb = lbv[c];
            Hq[(size_t)t * 1024 + c] = silu_acc(q); Hf[(size_t)t * 1024 + c] = lb + (1.f - lb) * sigmoid_f(f); Hk[(size_t)t * 1024 + c] = (1.f - lb) * sigmoid_f(-f); }
        if (tid < 288) { const int col = RWC_WL + tid; const float p = bf2f(pr[col]), pv = hasp ? bf2f(pp[col]) : 0.f; const float xs = p + (pv - p) * mu[3072 + tid];
            lin[tid] = tid < 64 ? tanhf(xs) : (tid < 128 ? xs : sigmoid_f(xs)); }
        __syncthreads();
#pragma unroll
        for (int cc = 0; cc < 2; ++cc) { const int c = tid + 512 * cc;
            float r = bf2f(pr[RWC_R + c]), k = bf2f(pr[RWC_K + c]), v = bf2f(pr[RWC_V + c]);
            const float rp = hasp ? bf2f(pp[RWC_R + c]) : 0.f, kp = hasp ? bf2f(pp[RWC_K + c]) : 0.f, vp = hasp ? bf2f(pp[RWC_V + c]) : 0.f;
            r = r + (rp - r) * mu[c]; k = k + (kp - k) * mu[1024 + c]; v = v + (vp - v) * mu[2048 + c];
            float wd = 0.f, ad = 0.f, gt = 0.f;
            for (int jj = 0; jj < 64; ++jj) { wd += lin[jj] * w2[jj * 1024 + c]; ad += lin[64 + jj] * a2[jj * 1024 + c]; }
            for (int jj = 0; jj < 160; ++jj) gt += lin[128 + jj] * g2[jj * 1024 + c];
            const float w_log = -softplus_f(-(w0[c] + wd)) - 0.5f; const float decay = -expf(w_log);
            const float a = sigmoid_f(a0[c] + ad);
            const float kkv = k * k_k[c]; const float ss = wave_sum(kkv * kkv); const float kk = kkv / fmaxf(sqrtf(ss), 1e-12f);
            const float k2 = k * (1.f + (a - 1.f) * k_a[c]);
            const float bs = wave_sum(r * k2 * r_k[c]);
            const size_t o = (size_t)t * 1024 + c;
            Rr[o] = r; Rw[o] = decay; Rk2[o] = k2; Rkk[o] = kk; Rkka[o] = kk * a; Rv[o] = v; Rgate[o] = gt; Rbonus[o] = bs * v; }
        __syncthreads();
    }
}
__device__ __forceinline__ void phase_even_scan(Frame& F, int u_lo) {
    if (F.wave != 0) return;
    int lane_ = F.lane; OPAQUE_V(lane_);
    const bf16* P = ws_bf(F, WS_P);
    for (int u = u_lo + F.bid; u < 32; u += F.G) {
        if (u < 16) {
            const int head = u >> 1, vb = u & 1, vcol = head * 128 + vb * 64 + lane_;
            const float* Hq = scr_f(F, S_HQ) + head * 128; const float* Hf = scr_f(F, S_HF) + head * 128; const float* Hk = scr_f(F, S_HK) + head * 128; float* Ho = scr_f(F, S_HO);
            float S[128];
#pragma unroll
            for (int d = 0; d < 128; ++d) S[d] = 0.f;
            for (int t = 0; t < SEQ; ++t) {
                const float v = bf2f(P[(size_t)t * LDP + HGC_I + vcol]);
                const float* q = Hq + (size_t)t * 1024; const float* f = Hf + (size_t)t * 1024; const float* k = Hk + (size_t)t * 1024;
                float o = 0.f;
#pragma unroll
                for (int d = 0; d < 128; ++d) { S[d] = f[d] * S[d] + k[d] * v; o += q[d] * S[d]; if ((d & 15) == 15) asm volatile("" ::: "memory"); }
                Ho[(size_t)t * 1024 + vcol] = o;
            }
        } else {
            const int head = u - 16, c = head * 64 + lane_;
            const float* Rr = scr_f(F, S_RR) + head * 64; const float* Rw = scr_f(F, S_RW) + head * 64; const float* Rk2 = scr_f(F, S_RK2) + head * 64;
            const float* Rkk = scr_f(F, S_RKK) + head * 64; const float* Rkka = scr_f(F, S_RKKA) + head * 64; const float* Rv = scr_f(F, S_RV); float* Ro = scr_f(F, S_RO);
            float S[64];
#pragma unroll
            for (int d = 0; d < 64; ++d) S[d] = 0.f;
            for (int t = 0; t < SEQ; ++t) {
                const size_t tb = (size_t)t * 1024;
                const float v = Rv[tb + c];
                float sa = 0.f;
#pragma unroll
                for (int d = 0; d < 64; ++d) sa += S[d] * Rkk[tb + d];
                sa = -sa;
                float o = 0.f;
#pragma unroll
                for (int d = 0; d < 64; ++d) { S[d] = S[d] * expf(Rw[tb + d]) + sa * Rkka[tb + d] + v * Rk2[tb + d]; o += S[d] * Rr[tb + d]; }
                Ro[tb + c] = o;
            }
        }
    }
}
__device__ __forceinline__ void phase_even_post(Frame& F, const Args& args, int layer) {
    const int j = layer >> 1, w = F.wave; int lane = F.lane; OPAQUE_V(lane);
    const bf16* P = ws_bf(F, WS_P); bf16* MIX = ws_bf(F, WS_MIX);
    const float* hgn = F_IN(7) + j * 1024; const float* lnw = F_IN(17) + j * 1024; const float* lnb = F_IN(18) + j * 1024;
    const float* Ho = scr_f(F, S_HO); const float* Ro = scr_f(F, S_RO); const float* Rgate = scr_f(F, S_RGATE); const float* Rbonus = scr_f(F, S_RBONUS);
    for (int t = F.bid; t < SEQ; t += F.G) {
        const size_t tb = (size_t)t * 1024;
        { const int c0 = w * 128 + lane, c1 = c0 + 64; const float o0 = Ho[tb + c0], o1 = Ho[tb + c1];
          const float ss = wave_sum(o0 * o0 + o1 * o1); const float r = __builtin_amdgcn_rsqf(ss * (1.f / 128.f) + EPS);
          const float g0 = bf2f(P[(size_t)t * LDP + HGC_G + c0]), g1 = bf2f(P[(size_t)t * LDP + HGC_G + c1]);
          MIX[(size_t)t * DM + c0] = (bf16)f2bf(o0 * r * hgn[c0] * sigmoid_f(g0)); MIX[(size_t)t * DM + c1] = (bf16)f2bf(o1 * r * hgn[c1] * sigmoid_f(g1)); }
#pragma unroll
        for (int hh = 0; hh < 2; ++hh) { const int c = (w + 8 * hh) * 64 + lane; const float o = Ro[tb + c];
            const float mu = wave_sum(o) * (1.f / 64.f); const float d = o - mu; const float var = wave_sum(d * d) * (1.f / 64.f);
            float y = d * __builtin_amdgcn_rsqf(var + 64e-5f) * lnw[c] + lnb[c]; y = (y + Rbonus[tb + c]) * Rgate[tb + c];
            MIX[(size_t)t * DM + 1024 + c] = (bf16)f2bf(y); }
    }
}

__device__ __forceinline__ void phase_odd_pre(Frame& F, const Args& args, int layer) {
    const int j = layer >> 1; int tid = F.tid; OPAQUE_V(tid);
    const bf16* P = ws_bf(F, WS_P);
    const float* ib = F_IN(21) + j * 4; const float* fb = F_IN(22) + j * 4; const float* cw = F_IN(24) + (size_t)j * 4 * 1536; const float* cb = F_IN(25) + j * 1536;
    const float* dtb = F_IN(26) + j * 16; const float* Alog = F_IN(27) + j * 16;
    float* Mq = scr_f(F, S_MQ); float* Mk = scr_f(F, S_MK); float* sm = scr_f(F, S_SMALL);
    float* Bx = scr_f(F, S_BX); float* BB = scr_f(F, S_BB); float* BC = scr_f(F, S_BC);
    for (int t = F.bid; t < SEQ; t += F.G) {
        const bf16* pr = P + (size_t)t * LDP;
        Mq[(size_t)t * 512 + tid] = bf2f(pr[MLC_Q + tid]) * 0.08838834764831845f; Mk[(size_t)t * 512 + tid] = bf2f(pr[MLC_K + tid]);
        if (tid < 4) { const float ig = bf2f(pr[MLC_I + tid]) + ib[tid], fg = bf2f(pr[MLC_F + tid]) + fb[tid];
            const float ip = 15.f * tanhf(ig * (1.f / 15.f)), fp = 15.f * tanhf(fg * (1.f / 15.f));
            sm[SM_EI + (size_t)t * 4 + tid] = ip; sm[SM_F + (size_t)t * 4 + tid] = -softplus_acc(-fp); }
        if (tid >= 64 && tid < 80) { const int hh = tid - 64; const float dt = softplus_acc(bf2f(pr[MBC_DT + hh]) + dtb[hh]);
            sm[SM_DT + (size_t)t * 16 + hh] = dt; sm[SM_DA + (size_t)t * 16 + hh] = -expf(Alog[hh]) * dt; }
#pragma unroll
        for (int cc = 0; cc < 3; ++cc) { const int c = tid + 512 * cc; float acc = cb[c];
#pragma unroll
            for (int jj = 0; jj < 4; ++jj) { const int tt = t - 3 + jj; if (tt >= 0) acc += cw[jj * 1536 + c] * bf2f(P[(size_t)tt * LDP + MBC_X + c]); }
            const float s = silu_acc(acc);
            if (c < 1024) Bx[(size_t)t * 1024 + c] = s; else if (c < 1280) BB[(size_t)t * 256 + (c - 1024)] = s; else BC[(size_t)t * 256 + (c - 1280)] = s; }
    }
}
__device__ __forceinline__ void phase_odd_scan(Frame& F, int u_lo, int u_hi) {
    if (F.wave != 0) return;
    int lane_ = F.lane; OPAQUE_V(lane_);
    const bf16* P = ws_bf(F, WS_P);
    float* sm = scr_f(F, S_SMALL);
    for (int u = u_lo + F.bid; u < u_hi; u += F.G) {
        if (u < 20) {
            const int head = u / 5, blk = u % 5, col = blk * 64 + lane_;
            const float* Mq = scr_f(F, S_MQ) + head * 128; const float* Mk = scr_f(F, S_MK) + head * 128; float* Mnum = scr_f(F, S_MNUM);
            float S[128];
#pragma unroll
            for (int d = 0; d < 128; ++d) S[d] = 0.f;
            for (int t = 0; t < SEQ; ++t) {
                const float ei = expf(sm[SM_EI + (size_t)t * 4 + head]), f = expf(sm[SM_F + (size_t)t * 4 + head]);
                float vv = 0.f; if (col < 256) vv = bf2f(P[(size_t)t * LDP + MLC_V + head * 256 + col]); else if (col == 256) vv = 1.f;
                const float ev = ei * vv;
                const float* q = Mq + (size_t)t * 512; const float* k = Mk + (size_t)t * 512;
                float num = 0.f;
#pragma unroll
                for (int d = 0; d < 128; ++d) { S[d] = f * S[d] + ev * k[d]; num += q[d] * S[d]; if ((d & 15) == 15) asm volatile("" ::: "memory"); }
                if (col < 256) Mnum[(size_t)t * 1024 + head * 256 + col] = num; else if (col == 256) sm[SM_DEN + (size_t)t * 4 + head] = num;
            }
        } else {
            const int head = u - 20, g = head >> 3, c = head * 64 + lane_;
            const float* Bx = scr_f(F, S_BX); const float* BB = scr_f(F, S_BB) + g * 128; const float* BC = scr_f(F, S_BC) + g * 128; float* By = scr_f(F, S_BY);
            float S[128];
#pragma unroll
            for (int d = 0; d < 128; ++d) S[d] = 0.f;
            for (int t = 0; t < SEQ; ++t) {
                const float x = Bx[(size_t)t * 1024 + c], dt = sm[SM_DT + (size_t)t * 16 + head], dA = expf(sm[SM_DA + (size_t)t * 16 + head]);
                const float dx = dt * x; const float* B = BB + (size_t)t * 256; const float* C = BC + (size_t)t * 256;
                float y = 0.f;
#pragma unroll
                for (int d = 0; d < 128; ++d) { S[d] = dA * S[d] + dx * B[d]; y += C[d] * S[d]; if ((d & 15) == 15) asm volatile("" ::: "memory"); }
                By[(size_t)t * 1024 + c] = y;
            }
        }
    }
}
__device__ __forceinline__ void phase_odd_post(Frame& F, const Args& args, int layer) {
    const int j = layer >> 1, w = F.wave; int tid = F.tid; OPAQUE_V(tid); const int lane = tid & 63;
    const bf16* P = ws_bf(F, WS_P); bf16* MIX = ws_bf(F, WS_MIX);
    const float* mln = F_IN(23) + j * 1024; const float* Dp = F_IN(28) + j * 16; const float* mbn = F_IN(29) + j * 1024;
    const float* Mnum = scr_f(F, S_MNUM); const float* sm = scr_f(F, S_SMALL); const float* Bx = scr_f(F, S_BX); const float* By = scr_f(F, S_BY);
    LAS float* red = (LAS float*)(F.lds);
    for (int t = F.bid; t < SEQ; t += F.G) {
        const bf16* pr = P + (size_t)t * LDP; const size_t tb = (size_t)t * 1024;
        if (w < 4) { const float den = sm[SM_DEN + (size_t)t * 4 + w]; const float dn = 1.0f / fmaxf(fabsf(den), sm[SM_EM_POST + (size_t)t * 4 + w]);
            float hv[4]; float ss = 0.f;
#pragma unroll
            for (int i = 0; i < 4; ++i) { hv[i] = Mnum[tb + w * 256 + lane + 64 * i] * dn; ss += hv[i] * hv[i]; }
            ss = wave_sum(ss); const float r = __builtin_amdgcn_rsqf(ss * (1.f / 256.f) + EPS);
#pragma unroll
            for (int i = 0; i < 4; ++i) { const int c = w * 256 + lane + 64 * i; const float og = bf2f(pr[MLC_O + c]);
                MIX[(size_t)t * DM + c] = (bf16)f2bf(hv[i] * r * mln[c] * sigmoid_f(og)); } }
        float yv[2];
#pragma unroll
        for (int cc = 0; cc < 2; ++cc) { const int c = tid + 512 * cc; const float z = bf2f(pr[MBC_Z + c]);
            yv[cc] = (By[tb + c] + Bx[tb + c] * Dp[c >> 6]) * silu_acc(z);
            const float s = wave_sum(yv[cc] * yv[cc]); if (lane == 0) red[w * 2 + cc] = s; }
        __syncthreads();
#pragma unroll
        for (int cc = 0; cc < 2; ++cc) { float tot = 0.f;
#pragma unroll
            for (int ww = 0; ww < 8; ++ww) tot += red[ww * 2 + cc];
            const int c = tid + 512 * cc; const float r = __builtin_amdgcn_rsqf(tot * (1.f / 512.f) + EPS);
            MIX[(size_t)t * DM + 1024 + c] = (bf16)f2bf(yv[cc] * r * mbn[c]); }
        __syncthreads();
    }
}

typedef short bf16x8v __attribute__((ext_vector_type(8)));
typedef float f32x16 __attribute__((ext_vector_type(16)));
constexpr int NCHUNK = SEQ / 64;
constexpr int S_U = 13;
constexpr int S_HS = 15;
constexpr int S_HD = 16;
constexpr int S_RMQ = 17, S_RN = 18, S_ROL = 19, S_RS = 20;
constexpr int S_MS = 16;
constexpr int S_BU = 18;
constexpr int S_BS = 20;
constexpr int S_OSM = 21;

__device__ __forceinline__ void mma32(f32x16& acc, const LAS unsigned char* A, int pa, const LAS unsigned char* Bt, int pb, int ksteps, int lane) {
    const LAS unsigned char* ap = A + (lane & 31) * pa + (lane >> 5) * 16;
    const LAS unsigned char* bp = Bt + (lane & 31) * pb + (lane >> 5) * 16;
    for (int ks = 0; ks < ksteps; ++ks) {
        const bf16x8v a = *(const LAS bf16x8v*)(ap + ks * 32), b = *(const LAS bf16x8v*)(bp + ks * 32);
        acc = __builtin_amdgcn_mfma_f32_32x32x16_bf16(a, b, acc, 0, 0, 0);
    }
}
template <int KS> __device__ __forceinline__ void mma32_gb(f32x16& acc, const LAS unsigned char* A, int pa, const unsigned char* Bt, int pb, int lane) {
    const LAS unsigned char* ap = A + (lane & 31) * pa + (lane >> 5) * 16;
    const unsigned char* bp = Bt + (size_t)(lane & 31) * pb + (lane >> 5) * 16;
    bf16x8v b[KS];
#pragma unroll
    for (int ks = 0; ks < KS; ++ks) b[ks] = *(const bf16x8v*)(bp + ks * 32);
#pragma unroll
    for (int ks = 0; ks < KS; ++ks) { const bf16x8v a = *(const LAS bf16x8v*)(ap + ks * 32); acc = __builtin_amdgcn_mfma_f32_32x32x16_bf16(a, b[ks], acc, 0, 0, 0); }
}
__device__ __forceinline__ void mma32_gbl(f32x16& acc, const LAS unsigned char* A, int pa, const unsigned char* Bt, int pb, int ksteps, int lane) {
    const LAS unsigned char* ap = A + (lane & 31) * pa + (lane >> 5) * 16;
    const unsigned char* bp = Bt + (size_t)(lane & 31) * pb + (lane >> 5) * 16;
    for (int ks = 0; ks < ksteps; ++ks) {
        const bf16x8v a = *(const LAS bf16x8v*)(ap + ks * 32); const bf16x8v b = *(const bf16x8v*)(bp + ks * 32);
        acc = __builtin_amdgcn_mfma_f32_32x32x16_bf16(a, b, acc, 0, 0, 0);
    }
}
#define ACC_ROW(i, lane) (((i) & 3) + 8 * ((i) >> 2) + 4 * ((lane) >> 5))
__device__ __forceinline__ f32x16 zero16() { f32x16 z;
#pragma unroll
    for (int i = 0; i < 16; ++i) z[i] = 0.f;
    return z; }
__device__ __forceinline__ float exp_c(float x) { return __expf(fminf(x, 80.f)); }

__device__ __forceinline__ void unpack8(const v4u p, float (&o)[8]) {
    o[0] = __builtin_bit_cast(float, p.x << 16); o[1] = __builtin_bit_cast(float, p.x & 0xffff0000u); o[2] = __builtin_bit_cast(float, p.y << 16); o[3] = __builtin_bit_cast(float, p.y & 0xffff0000u);
    o[4] = __builtin_bit_cast(float, p.z << 16); o[5] = __builtin_bit_cast(float, p.z & 0xffff0000u); o[6] = __builtin_bit_cast(float, p.w << 16); o[7] = __builtin_bit_cast(float, p.w & 0xffff0000u);
}
__device__ __forceinline__ void load8f(const float* p, float (&o)[8]) { const f32x4 a = *(const f32x4*)p, b = *(const f32x4*)(p + 4); o[0] = a[0]; o[1] = a[1]; o[2] = a[2]; o[3] = a[3]; o[4] = b[0]; o[5] = b[1]; o[6] = b[2]; o[7] = b[3]; }
__device__ __forceinline__ void store8f(float* p, const float (&o)[8]) { *(f32x4*)p = (f32x4){o[0], o[1], o[2], o[3]}; *(f32x4*)(p + 4) = (f32x4){o[4], o[5], o[6], o[7]}; }
__device__ __forceinline__ v4u pack8(const float (&o)[8]) { return (v4u){pk2(o[0], o[1]), pk2(o[2], o[3]), pk2(o[4], o[5]), pk2(o[6], o[7])}; }
template <int W> __device__ __forceinline__ float group_sum(float v) {
    if constexpr (W > 1) v = dpp_add<0xB1>(v);
    if constexpr (W > 2) v = dpp_add<0x4E>(v);
    if constexpr (W > 4) v = dpp_add<0x141>(v);
    if constexpr (W > 8) v = dpp_add<0x140>(v);
    if constexpr (W > 16) v += xshfl<16>(v);
    if constexpr (W > 32) v += xshfl<32>(v);
    return v;
}
__device__ __forceinline__ void phase_even_post2(Frame& F, const Args& args, int layer) {
    const int j = layer >> 1; int lane = F.lane; OPAQUE_V(lane);
    const int gw = F.bid * NWAVES + F.wave, NGW = F.G * NWAVES;
    const bf16* P = ws_bf(F, WS_P); bf16* MIX = ws_bf(F, WS_MIX);
    const float* hgn = F_IN(7) + j * 1024; const float* lnw = F_IN(17) + j * 1024; const float* lnb = F_IN(18) + j * 1024;
    const float* Ho = scr_f(F, S_HO); const float* Ro = scr_f(F, S_RO); const bf16* Rgate = (const bf16*)scr_f(F, S_RGATE); const float* Rbs = scr_f(F, S_RBONUS); const bf16* Rv = (const bf16*)scr_f(F, S_RV);
    for (int t = gw; t < SEQ; t += NGW) {
        const size_t tb = (size_t)t * 1024;
        float o[2][8], g[2][8], ro[2][8], ga[2][8], bo[2][8];
#pragma unroll
        for (int it = 0; it < 2; ++it) { const int c0 = (lane + 64 * it) * 8;
            load8f(Ho + tb + c0, o[it]); unpack8(*(const v4u*)(P + (size_t)t * LDP + HGC_G + c0), g[it]);
            load8f(Ro + tb + c0, ro[it]); unpack8(*(const v4u*)(Rgate + tb + c0), ga[it]); unpack8(*(const v4u*)(Rv + tb + c0), bo[it]); { const float bsc = Rbs[(size_t)t * 16 + (c0 >> 6)];
#pragma unroll
                for (int e = 0; e < 8; ++e) bo[it][e] *= bsc; } }
#pragma unroll
        for (int it = 0; it < 2; ++it) { const int c0 = (lane + 64 * it) * 8; float nv[8], out[8]; load8f(hgn + c0, nv);
            float ss = 0.f;
#pragma unroll
            for (int e = 0; e < 8; ++e) ss += o[it][e] * o[it][e];
            ss = group_sum<16>(ss); const float r = __builtin_amdgcn_rsqf(ss * (1.f / 128.f) + EPS);
#pragma unroll
            for (int e = 0; e < 8; ++e) out[e] = o[it][e] * r * nv[e] * sigmoid_f(g[it][e]);
            *(v4u*)(MIX + (size_t)t * DM + c0) = pack8(out); }
#pragma unroll
        for (int it = 0; it < 2; ++it) { const int c0 = (lane + 64 * it) * 8; float wv[8], bv[8], out[8]; load8f(lnw + c0, wv); load8f(lnb + c0, bv);
            float s1 = 0.f;
#pragma unroll
            for (int e = 0; e < 8; ++e) s1 += ro[it][e];
            const float mu = group_sum<8>(s1) * (1.f / 64.f); float s2 = 0.f;
#pragma unroll
            for (int e = 0; e < 8; ++e) { ro[it][e] -= mu; s2 += ro[it][e] * ro[it][e]; }
            const float rs = __builtin_amdgcn_rsqf(group_sum<8>(s2) * (1.f / 64.f) + 64e-5f);
#pragma unroll
            for (int e = 0; e < 8; ++e) out[e] = (ro[it][e] * rs * wv[e] + bv[e] + bo[it][e]) * ga[it][e];
            *(v4u*)(MIX + (size_t)t * DM + 1024 + c0) = pack8(out); }
    }
}
__device__ __forceinline__ void phase_odd_post2(Frame& F, const Args& args, int layer) {
    const int j = layer >> 1; int lane = F.lane; OPAQUE_V(lane);
    const int gw = F.bid * NWAVES + F.wave, NGW = F.G * NWAVES;
    const bf16* P = ws_bf(F, WS_P); bf16* MIX = ws_bf(F, WS_MIX);
    const float* mln = F_IN(23) + j * 1024; const float* Dp = F_IN(28) + j * 16; const float* mbn = F_IN(29) + j * 1024;
    const float* Mnum = scr_f(F, S_MNUM); const float* sm = scr_f(F, S_SMALL); const bf16* Bx = (const bf16*)scr_f(F, S_BX); const float* By = scr_f(F, S_BY);
    for (int t = gw; t < SEQ; t += NGW) {
        const size_t tb = (size_t)t * 1024; const bf16* pr = P + (size_t)t * LDP;
        float nu[2][8], og[2][8], by[2][8], bx[2][8], z[2][8], den[2], em[2];
#pragma unroll
        for (int it = 0; it < 2; ++it) { const int c0 = (lane + 64 * it) * 8;
            load8f(Mnum + tb + c0, nu[it]); unpack8(*(const v4u*)(pr + MLC_O + c0), og[it]); den[it] = sm[SM_DEN + (size_t)t * 4 + (c0 >> 8)]; em[it] = sm[SM_EM_POST + (size_t)t * 4 + (c0 >> 8)];
            load8f(By + tb + c0, by[it]); unpack8(*(const v4u*)(Bx + tb + c0), bx[it]); unpack8(*(const v4u*)(pr + MBC_Z + c0), z[it]); }
#pragma unroll
        for (int it = 0; it < 2; ++it) { const int c0 = (lane + 64 * it) * 8; float nv[8], out[8]; load8f(mln + c0, nv);
            const float dn = __builtin_amdgcn_rcpf(fmaxf(fabsf(den[it]), em[it])); float ss = 0.f;
#pragma unroll
            for (int e = 0; e < 8; ++e) { nu[it][e] *= dn; ss += nu[it][e] * nu[it][e]; }
            ss = group_sum<32>(ss); const float r = __builtin_amdgcn_rsqf(ss * (1.f / 256.f) + EPS);
#pragma unroll
            for (int e = 0; e < 8; ++e) out[e] = nu[it][e] * r * nv[e] * sigmoid_f(og[it][e]);
            *(v4u*)(MIX + (size_t)t * DM + c0) = pack8(out); }
#pragma unroll
        for (int it = 0; it < 2; ++it) { const int c0 = (lane + 64 * it) * 8; float nv[8], out[8]; load8f(mbn + c0, nv); const float dsk = Dp[c0 >> 6];
            float ss = 0.f;
#pragma unroll
            for (int e = 0; e < 8; ++e) { by[it][e] = (by[it][e] + bx[it][e] * dsk) * silu_acc(z[it][e]); ss += by[it][e] * by[it][e]; }
            ss = group_sum<64>(ss); const float r = __builtin_amdgcn_rsqf(ss * (1.f / 512.f) + EPS);
#pragma unroll
            for (int e = 0; e < 8; ++e) out[e] = by[it][e] * r * nv[e];
            *(v4u*)(MIX + (size_t)t * DM + 1024 + c0) = pack8(out); }
    }
}
__device__ __forceinline__ void phase_odd_pre2(Frame& F, const Args& args, int layer) {
    const int j = layer >> 1; int lane = F.lane; OPAQUE_V(lane);
    const int gw = F.bid * NWAVES + F.wave, NGW = F.G * NWAVES;
    const bf16* P = ws_bf(F, WS_P);
    const float* ib = F_IN(21) + j * 4; const float* fb = F_IN(22) + j * 4; const float* cw = F_IN(24) + (size_t)j * 4 * 1536; const float* cb = F_IN(25) + j * 1536;
    const float* dtb = F_IN(26) + j * 16; const float* Alog = F_IN(27) + j * 16;
    bf16* Mq = (bf16*)scr_f(F, S_MQ); bf16* Mk = (bf16*)scr_f(F, S_MK); float* sm = scr_f(F, S_SMALL);
    bf16* Bx = (bf16*)scr_f(F, S_BX); bf16* BB = (bf16*)scr_f(F, S_BB); bf16* BC = (bf16*)scr_f(F, S_BC);
    for (int t = gw; t < SEQ; t += NGW) {
        const bf16* pr = P + (size_t)t * LDP;
        { const int c0 = lane * 8; float q[8], k[8]; unpack8(*(const v4u*)(pr + MLC_Q + c0), q); unpack8(*(const v4u*)(pr + MLC_K + c0), k);
          float qs = 0.08838834764831845f; OPAQUE_V(qs);
#pragma unroll
          for (int e = 0; e < 8; ++e) q[e] *= qs;
          *(v4u*)(Mq + (size_t)t * 512 + c0) = pack8(q); *(v4u*)(Mk + (size_t)t * 512 + c0) = pack8(k); }
        if (lane < 4) { const float ig = bf2f(pr[MLC_I + lane]) + ib[lane], fg = bf2f(pr[MLC_F + lane]) + fb[lane];
            const float ip = 15.f * tanh_f(ig * (1.f / 15.f)), fp = 15.f * tanh_f(fg * (1.f / 15.f));
            sm[SM_EI + (size_t)t * 4 + lane] = ip; sm[SM_F + (size_t)t * 4 + lane] = -softplus_acc(-fp); }
        if (lane >= 8 && lane < 24) { const int hh = lane - 8; const float dt = softplus_acc(bf2f(pr[MBC_DT + hh]) + dtb[hh]);
            sm[SM_DT + (size_t)t * 16 + hh] = dt; sm[SM_DA + (size_t)t * 16 + hh] = -__expf(Alog[hh]) * dt; }
#pragma unroll
        for (int it = 0; it < 3; ++it) { const int c0 = (lane + 64 * it) * 8; float acc[8]; load8f(cb + c0, acc);
#pragma unroll
            for (int jj = 0; jj < 4; ++jj) { const int tt = t - 3 + jj; if (tt >= 0) { float xv[8], wv[8]; unpack8(*(const v4u*)(P + (size_t)tt * LDP + MBC_X + c0), xv); load8f(cw + jj * 1536 + c0, wv);
#pragma unroll
                    for (int e = 0; e < 8; ++e) acc[e] += wv[e] * xv[e]; } }
#pragma unroll
            for (int e = 0; e < 8; ++e) acc[e] = silu_acc(acc[e]);
            if (c0 < 1024) *(v4u*)(Bx + (size_t)t * 1024 + c0) = pack8(acc); else if (c0 < 1280) *(v4u*)(BB + (size_t)t * 256 + (c0 - 1024)) = pack8(acc); else *(v4u*)(BC + (size_t)t * 256 + (c0 - 1280)) = pack8(acc); }
    }
}

constexpr int PE_LBV = 0, PE_LIN = 8192, PE_LINP = 592, PE_STG = 28672, PE_STGW = 12800;
__device__ __forceinline__ float half_sum32(float v) {
    v = row16_sum(v); v += xshfl<16>(v);
    return v;
}
__device__ __forceinline__ void phase_even_pre2(Frame& F, const Args& args, int layer) {
    const int j = layer >> 1; int tid = F.tid; OPAQUE_V(tid);
    const int lane = tid & 63, w = F.wave, cl = lane & 31;
    const bf16* P = ws_bf(F, WS_P);
    LAS unsigned char* L = F.lds;
    const float* mu = F_IN(8) + (size_t)j * 3360; const float* w0 = F_IN(9) + j * 1024; const float* a0 = F_IN(11) + j * 1024;
    const float* k_k = F_IN(14) + j * 1024; const float* k_a = F_IN(15) + j * 1024; const float* r_k = F_IN(16) + j * 1024;
    const bf16* lora = ws_bf(F, WS_LORA) + (size_t)j * LORA_LAYER;
    bf16* Rr = (bf16*)scr_f(F, S_RR); _Float16* Rw = (_Float16*)scr_f(F, S_RW); bf16* Rk2 = (bf16*)scr_f(F, S_RK2); bf16* Rkk = (bf16*)scr_f(F, S_RKK); bf16* Rkka = (bf16*)scr_f(F, S_RKKA);
    bf16* Rv = (bf16*)scr_f(F, S_RV); bf16* Rgate = (bf16*)scr_f(F, S_RGATE); float* Rbs = scr_f(F, S_RBONUS);
    for (int tile = F.bid; tile < SEQ / 32; tile += F.G) {
        const size_t t0 = (size_t)tile * 32;
        { const int tl = tid >> 4, jq = tid & 15; const size_t t = t0 + tl; const bf16* pr = P + t * LDP; const bool hasp = t > 0;
#pragma unroll
          for (int i = 0; i < 18; ++i) { const int jj = jq + 16 * i, col = RWC_WL + jj; const float p = bf2f(pr[col]), pv = hasp ? bf2f(pr[col - LDP]) : 0.f; const float xs = p + (pv - p) * mu[3072 + jj];
              const float val = jj < 64 ? tanh_f(xs) : (jj < 128 ? xs : sigmoid_f(xs));
              *(LAS bf16*)(L + PE_LIN + tl * PE_LINP + jj * 2) = (bf16)f2bf(val); } }
        __syncthreads();
        for (int hh = 0; hh < 2; ++hh) { const int head = w + 8 * hh;
            LAS unsigned char* stg = L + PE_STG + w * PE_STGW;
            v4u pc[15];
#pragma unroll
            for (int a = 0; a < 3; ++a)
#pragma unroll
                for (int i = 0; i < 5; ++i) { const int row = (lane >> 3) + 8 * i; const long tt = (long)t0 - 1 + row;
                    pc[a * 5 + i] = (row < 33 && tt >= 0) ? *(const v4u*)(P + (size_t)tt * LDP + RWC_R + a * 1024 + head * 64 + (lane & 7) * 8) : (v4u){0u, 0u, 0u, 0u}; }
#pragma unroll
            for (int ct = 0; ct < 2; ++ct) { const int crow = head * 64 + ct * 32; f32x16 gt = zero16();
                mma32_gbl(gt, L + PE_LIN + 256, PE_LINP, (const unsigned char*)(lora + LORA_G2 + (size_t)crow * 160), 320, 10, lane);
#pragma unroll
                for (int i = 0; i < 16; ++i) { int trow = ACC_ROW(i, lane); OPAQUE_V(trow); Rgate[(t0 + trow) * 1024 + crow + cl] = (bf16)f2bf(gt[i]); } }
            LDS_WAIT(); asm volatile("" ::: "memory");
#pragma unroll
            for (int a = 0; a < 3; ++a)
#pragma unroll
                for (int i = 0; i < 5; ++i) { const int row = (lane >> 3) + 8 * i; if (row < 33) *(LAS v4u*)(stg + row * 384 + a * 128 + (lane & 7) * 16) = pc[a * 5 + i]; }
            LDS_WAIT(); asm volatile("" ::: "memory");
            f32x16 wd[2], ad[2];
#pragma unroll
            for (int ct = 0; ct < 2; ++ct) { const int crow = head * 64 + ct * 32; wd[ct] = zero16(); ad[ct] = zero16();
                mma32_gbl(wd[ct], L + PE_LIN, PE_LINP, (const unsigned char*)(lora + (size_t)crow * 64), 128, 4, lane);
                mma32_gbl(ad[ct], L + PE_LIN + 128, PE_LINP, (const unsigned char*)(lora + LORA_A2 + (size_t)crow * 64), 128, 4, lane); }
            float pw0[2], pa0[2], pkk[2], pka[2], prk[2], pmr[2], pmk[2], pmv[2];
#pragma unroll
            for (int ct = 0; ct < 2; ++ct) { const int c = head * 64 + ct * 32 + cl; pw0[ct] = w0[c]; pa0[ct] = a0[c]; pkk[ct] = k_k[c]; pka[ct] = k_a[c]; prk[ct] = r_k[c]; pmr[ct] = mu[c]; pmk[ct] = mu[1024 + c]; pmv[ct] = mu[2048 + c]; }
#pragma unroll
            for (int i = 0; i < 16; ++i) { int trow = ACC_ROW(i, lane); OPAQUE_V(trow); const size_t t = t0 + trow;
                float rr[2], kv[2], vv[2], av[2], kkv[2], k2[2], lwv[2]; float ss = 0.f, bs = 0.f;
#pragma unroll
                for (int ct = 0; ct < 2; ++ct) { const int c = head * 64 + ct * 32 + cl;
                    const LAS bf16* sp = (const LAS bf16*)(stg + (trow + 1) * 384) + ct * 32 + cl; const LAS bf16* spp = (const LAS bf16*)(stg + trow * 384) + ct * 32 + cl;
                    float r = bf2f(sp[0]), k = bf2f(sp[64]), v = bf2f(sp[128]);
                    const float rp = bf2f(spp[0]), kp = bf2f(spp[64]), vp = bf2f(spp[128]);
                    r = r + (rp - r) * pmr[ct]; k = k + (kp - k) * pmk[ct]; v = v + (vp - v) * pmv[ct];
                    const float w_log = -softplus_f(-(pw0[ct] + wd[ct][i])) - 0.5f; lwv[ct] = -__expf(w_log);
                    const float a = sigmoid_f(pa0[ct] + ad[ct][i]); av[ct] = a;
                    kkv[ct] = k * pkk[ct]; k2[ct] = k * (1.f + (a - 1.f) * pka[ct]); rr[ct] = r; kv[ct] = k; vv[ct] = v;
                    ss += kkv[ct] * kkv[ct]; bs += r * k2[ct] * prk[ct]; }
                ss = half_sum32(ss); bs = half_sum32(bs);
                const float inv = __builtin_amdgcn_rcpf(fmaxf(__builtin_amdgcn_sqrtf(ss), 1e-12f));
#pragma unroll
                for (int ct = 0; ct < 2; ++ct) { const size_t o = t * 1024 + head * 64 + ct * 32 + cl; const float kk = kkv[ct] * inv;
                    Rr[o] = (bf16)f2bf(rr[ct]); Rw[o] = (_Float16)lwv[ct]; Rk2[o] = (bf16)f2bf(k2[ct]); Rkk[o] = (bf16)f2bf(kk); Rkka[o] = (bf16)f2bf(kk * av[ct]); Rv[o] = (bf16)f2bf(vv[ct]); }
                if (cl == 0) Rbs[t * 16 + head] = bs;
                asm volatile("" ::: "memory"); }
        }
        __syncthreads();
    }
}

constexpr int HA_KT = 0, HA_VT = 18432, HA_SEG = 36864;
constexpr int HC_QT = 0, HC_KT = 17408, HC_QH = 34816, HC_VT = 52224, HC_SC = 70656, HC_ST = 79872, HC_SEG = 114688;
static_assert(HC_SEG + 2048 <= RING_BYTES, "HGRN2 LDS map");

#define HG_CUMSUM(SEGOFF)                                                                                         \
    float r[16]; { float run = 0.f;                                                                               \
        _Pragma("unroll") for (int i = 0; i < 16; ++i) { run += __logf((float)Hf[(row0 + i) * 1024 + h * 128 + d]); r[i] = run; } \
        segtot[seg * 128 + d] = run; }                                                                            \
    __syncthreads();                                                                                              \
    float off = 0.f, tot = 0.f; { _Pragma("unroll") for (int s = 0; s < 4; ++s) { const float sv = segtot[s * 128 + d]; tot += sv; if (s < seg) off += sv; } } \
    const float mid = segtot[d] + segtot[128 + d];

__device__ __forceinline__ void hg_load_vt(const bf16* P, LAS unsigned char* VT, size_t row0, int h, int d, int seg) {
    unsigned pk[8];
#pragma unroll
    for (int i = 0; i < 8; ++i) { const unsigned lo = P[(row0 + 2 * i) * LDP + HGC_I + h * 128 + d], hi = P[(row0 + 2 * i + 1) * LDP + HGC_I + h * 128 + d]; pk[i] = lo | (hi << 16); }
    LAS v4u* dst = (LAS v4u*)(VT + d * 144 + seg * 32);
    dst[0] = (v4u){pk[0], pk[1], pk[2], pk[3]}; dst[1] = (v4u){pk[4], pk[5], pk[6], pk[7]};
}

__device__ __forceinline__ void hg_phase_a(Frame& F) {
    int tid = F.tid; OPAQUE_V(tid);
    const int d = tid & 127, seg = tid >> 7, lane = tid & 63, w = F.wave;
    LAS unsigned char* L = F.lds; LAS float* segtot = (LAS float*)(L + HA_SEG);
    const _Float16* Hf = (const _Float16*)scr_f(F, S_HF); const bf16* Hk = (const bf16*)scr_f(F, S_HK); const bf16* P = ws_bf(F, WS_P);
    float* U = scr_f(F, S_U); float* Dk = scr_f(F, S_HD);
    for (int u = F.bid; u < NCHUNK * 8; u += F.G) {
        const int c = u >> 3, h = u & 7; const size_t row0 = (size_t)c * 64 + seg * 16;
        bf16 kraw[16]; unsigned vpk[8];
#pragma unroll
        for (int i = 0; i < 16; ++i) kraw[i] = Hk[(row0 + i) * 1024 + h * 128 + d];
#pragma unroll
        for (int i = 0; i < 8; ++i) { const unsigned lo = P[(row0 + 2 * i) * LDP + HGC_I + h * 128 + d], hi = P[(row0 + 2 * i + 1) * LDP + HGC_I + h * 128 + d]; vpk[i] = lo | (hi << 16); }
        HG_CUMSUM(HA_SEG)
        (void)mid;
        { unsigned pk[8];
#pragma unroll
          for (int i = 0; i < 8; ++i) { const float k0 = bf2f(kraw[2 * i]) * __expf(tot - (off + r[2 * i])), k1 = bf2f(kraw[2 * i + 1]) * __expf(tot - (off + r[2 * i + 1])); pk[i] = pk2(k0, k1); }
          LAS v4u* dst = (LAS v4u*)(L + HA_KT + d * 144 + seg * 32);
          dst[0] = (v4u){pk[0], pk[1], pk[2], pk[3]}; dst[1] = (v4u){pk[4], pk[5], pk[6], pk[7]}; }
        { LAS v4u* dst = (LAS v4u*)(L + HA_VT + d * 144 + seg * 32); dst[0] = (v4u){vpk[0], vpk[1], vpk[2], vpk[3]}; dst[1] = (v4u){vpk[4], vpk[5], vpk[6], vpk[7]}; }
        if (seg == 0) Dk[(size_t)u * 128 + d] = __expf(tot);
        __syncthreads();
        { const int vi = w >> 1;
#pragma unroll
          for (int jj = 0; jj < 2; ++jj) { const int dj = (w & 1) * 2 + jj; f32x16 acc = zero16();
              mma32(acc, L + HA_VT + vi * 32 * 144, 144, L + HA_KT + dj * 32 * 144, 144, 4, lane);
              float* up = U + ((size_t)u * 128 + vi * 32) * 128 + dj * 32 + (lane & 31);
#pragma unroll
              for (int i = 0; i < 16; ++i) up[(size_t)ACC_ROW(i, lane) * 128] = acc[i]; } }
        __syncthreads();
    }
}
__device__ __forceinline__ void hg_phase_b(Frame& F, int wg_lo) {
    if (F.bid < wg_lo) return;
    int tid = F.tid; OPAQUE_V(tid);
    const float* U = scr_f(F, S_U); const float* Dk = scr_f(F, S_HD); bf16* Sb = (bf16*)scr_f(F, S_HS);
    for (int e = (F.bid - wg_lo) * NTHREADS + tid; e < 8 * 128 * 128; e += (F.G - wg_lo) * NTHREADS) {
        const int h = e >> 14, vd = e & 16383, d = e & 127; float S = 0.f;
        for (int c0 = 0; c0 < NCHUNK; c0 += 16) { float uv[16], dk[16];
#pragma unroll
            for (int i = 0; i < 16; ++i) { const size_t un = (size_t)(c0 + i) * 8 + h; uv[i] = U[un * 16384 + vd]; dk[i] = Dk[un * 128 + d]; }
#pragma unroll
            for (int i = 0; i < 16; ++i) { const size_t un = (size_t)(c0 + i) * 8 + h; Sb[un * 16384 + vd] = (bf16)f2bf(S); S = dk[i] * S + uv[i]; } }
    }
}
__device__ __forceinline__ void hg_phase_c(Frame& F) {
    int tid = F.tid; OPAQUE_V(tid);
    const int d = tid & 127, seg = tid >> 7, lane = tid & 63, w = F.wave;
    LAS unsigned char* L = F.lds; LAS float* segtot = (LAS float*)(L + HC_SEG);
    const bf16* Hq = (const bf16*)scr_f(F, S_HQ); const _Float16* Hf = (const _Float16*)scr_f(F, S_HF); const bf16* Hk = (const bf16*)scr_f(F, S_HK); const bf16* P = ws_bf(F, WS_P);
    const bf16* Sb = (const bf16*)scr_f(F, S_HS); float* Ho = scr_f(F, S_HO);
    for (int u = F.bid; u < NCHUNK * 8; u += F.G) {
        const int c = u >> 3, h = u & 7; const size_t row0 = (size_t)c * 64 + seg * 16;
        bf16 qraw[16], kraw[16]; unsigned vpk[8]; v4u stp[4];
#pragma unroll
        for (int i = 0; i < 16; ++i) { qraw[i] = P[(row0 + i) * LDP + HGC_Q + h * 128 + d]; kraw[i] = Hk[(row0 + i) * 1024 + h * 128 + d]; }
#pragma unroll
        for (int i = 0; i < 8; ++i) { const unsigned lo = P[(row0 + 2 * i) * LDP + HGC_I + h * 128 + d], hi = P[(row0 + 2 * i + 1) * LDP + HGC_I + h * 128 + d]; vpk[i] = lo | (hi << 16); }
        { const v4u* src = (const v4u*)(Sb + (size_t)u * 16384);
#pragma unroll
          for (int i = 0; i < 4; ++i) stp[i] = src[tid + 512 * i]; }
        HG_CUMSUM(HC_SEG)
#pragma unroll
        for (int i = 0; i < 16; ++i) { const int t = seg * 16 + i; const float bc = off + r[i];
            const float q = bf2f(qraw[i]), k = bf2f(kraw[i]);
            *(LAS bf16*)(L + HC_QT + t * 272 + d * 2) = (bf16)f2bf(q * exp_c(bc - mid));
            *(LAS bf16*)(L + HC_KT + t * 272 + d * 2) = (bf16)f2bf(k * exp_c(mid - bc));
            *(LAS bf16*)(L + HC_QH + t * 272 + d * 2) = (bf16)f2bf(q * __expf(bc)); }
        (void)tot;
        { LAS v4u* dst = (LAS v4u*)(L + HC_VT + d * 144 + seg * 32); dst[0] = (v4u){vpk[0], vpk[1], vpk[2], vpk[3]}; dst[1] = (v4u){vpk[4], vpk[5], vpk[6], vpk[7]}; }
#pragma unroll
        for (int i = 0; i < 4; ++i) { const int p = tid + 512 * i; *(LAS v4u*)(L + HC_ST + (p >> 4) * 272 + (p & 15) * 16) = stp[i]; }
        __syncthreads();
        if (w < 4) { const int ti = w >> 1, sj = w & 1; f32x16 acc = zero16();
            if (sj <= ti) mma32(acc, L + HC_QT + ti * 32 * 272, 272, L + HC_KT + sj * 32 * 272, 272, 8, lane);
            const int s = sj * 32 + (lane & 31);
#pragma unroll
            for (int i = 0; i < 16; ++i) { const int t = ti * 32 + ACC_ROW(i, lane); *(LAS bf16*)(L + HC_SC + t * 144 + s * 2) = (bf16)f2bf(s <= t ? acc[i] : 0.f); } }
        __syncthreads();
        { const int ti = w >> 2, vj = w & 3; f32x16 acc = zero16();
          mma32(acc, L + HC_QH + ti * 32 * 272, 272, L + HC_ST + vj * 32 * 272, 272, 8, lane);
          mma32(acc, L + HC_SC + ti * 32 * 144, 144, L + HC_VT + vj * 32 * 144, 144, 4, lane);
          float* op = Ho + ((size_t)c * 64 + ti * 32) * 1024 + h * 128 + vj * 32 + (lane & 31);
#pragma unroll
          for (int i = 0; i < 16; ++i) op[(size_t)ACC_ROW(i, lane) * 1024] = acc[i]; }
        __syncthreads();
    }
}


constexpr int MA_XT = 0, MA_BT = 73728, MA_AS = 92160, MA_WS = 94208;
constexpr int MC_CI = 0, MC_BI = 17408, MC_CBR = 34816, MC_XT = 51200, MC_SCI = 88064, MC_AS = 124928, MC_DT = 126976, MC_EA = 129024;
static_assert(MC_EA + 2048 <= RING_BYTES, "Mamba LDS map");

__device__ __forceinline__ float wave_incl_scan(float x, int lane) {
    int lo = lane; asm volatile("" : "+v"(lo));
#pragma unroll
    for (int o = 1; o < 64; o <<= 1) { const float y = shfl_up_f(x, o, lo); if (lane >= o) x += y; }
    return x;
}
__device__ __forceinline__ void mb_phase_a(Frame& F) {
    int tid = F.tid; OPAQUE_V(tid);
    const int lane = tid & 63, w = F.wave;
    LAS unsigned char* L = F.lds; LAS float* as_ = (LAS float*)(L + MA_AS); LAS float* ws_ = (LAS float*)(L + MA_WS);
    const bf16* Bx = (const bf16*)scr_f(F, S_BX); const bf16* BB = (const bf16*)scr_f(F, S_BB); const float* sm = scr_f(F, S_SMALL);
    float* Um = scr_f(F, S_BU); float* osm = scr_f(F, S_OSM);
    for (int u = F.bid; u < NCHUNK * 2; u += F.G) {
        const int c = u >> 1, g = u & 1; const size_t t0 = (size_t)c * 64;
        bf16 xraw[64]; unsigned bpk[8];
        { const bf16* xp = Bx + t0 * 1024 + g * 512 + tid;
#pragma unroll
          for (int t = 0; t < 64; ++t) xraw[t] = xp[(size_t)t * 1024];
          const bf16* bp = BB + (t0 + (tid >> 7) * 16) * 256 + g * 128 + (tid & 127);
#pragma unroll
          for (int i = 0; i < 8; ++i) bpk[i] = (unsigned)bp[(size_t)(2 * i) * 256] | ((unsigned)bp[(size_t)(2 * i + 1) * 256] << 16); }
        { const int h = g * 8 + w; const float a = wave_incl_scan(sm[SM_DA + (t0 + lane) * 16 + h], lane); const float al = readlane_f(a, 63);
          as_[w * 64 + lane] = a; ws_[w * 64 + lane] = sm[SM_DT + (t0 + lane) * 16 + h] * __expf(al - a);
          if (lane == 0) osm[(size_t)c * 16 + h] = __expf(al); }
        __syncthreads();
        {
#pragma unroll
            for (int tb = 0; tb < 8; ++tb) { unsigned pk[4];
#pragma unroll
                for (int i = 0; i < 4; ++i) { const int t = tb * 8 + 2 * i; pk[i] = pk2(bf2f(xraw[t]) * ws_[w * 64 + t], bf2f(xraw[t + 1]) * ws_[w * 64 + t + 1]); }
                *(LAS v4u*)(L + MA_XT + w * 9216 + lane * 144 + tb * 16) = (v4u){pk[0], pk[1], pk[2], pk[3]}; }
            const int n = tid & 127, seg = tid >> 7;
            LAS v4u* dst = (LAS v4u*)(L + MA_BT + n * 144 + seg * 32); dst[0] = (v4u){bpk[0], bpk[1], bpk[2], bpk[3]}; dst[1] = (v4u){bpk[4], bpk[5], bpk[6], bpk[7]};
        }
        __syncthreads();
        { const int h = g * 8 + w;
#pragma unroll
          for (int pi = 0; pi < 2; ++pi)
#pragma unroll
              for (int nj = 0; nj < 4; ++nj) { f32x16 acc = zero16();
                  mma32(acc, L + MA_XT + w * 9216 + pi * 32 * 144, 144, L + MA_BT + nj * 32 * 144, 144, 4, lane);
                  float* up = Um + (((size_t)c * 16 + h) * 64 + pi * 32) * 128 + nj * 32 + (lane & 31);
#pragma unroll
                  for (int i = 0; i < 16; ++i) up[(size_t)ACC_ROW(i, lane) * 128] = acc[i]; } }
        __syncthreads();
    }
}
__device__ __forceinline__ void mb_phase_b(Frame& F) {
    int tid = F.tid; OPAQUE_V(tid);
    const float* Um = scr_f(F, S_BU); const float* osm = scr_f(F, S_OSM); bf16* Sb = (bf16*)scr_f(F, S_BS);
    for (int e = F.bid * NTHREADS + tid; e < 16 * 64 * 128; e += F.G * NTHREADS) {
        const int h = e >> 13, pn = e & 8191; float S = 0.f;
        for (int c0 = 0; c0 < NCHUNK; c0 += 8) { float uv[8], dk[8];
#pragma unroll
            for (int i = 0; i < 8; ++i) { const size_t un = (size_t)(c0 + i) * 16 + h; uv[i] = Um[un * 8192 + pn]; dk[i] = osm[un]; }
#pragma unroll
            for (int i = 0; i < 8; ++i) { const size_t un = (size_t)(c0 + i) * 16 + h; Sb[un * 8192 + pn] = (bf16)f2bf(S); S = dk[i] * S + uv[i]; } }
    }
}
__device__ __forceinline__ void mb_phase_c(Frame& F) {
    int tid = F.tid; OPAQUE_V(tid);
    const int lane = tid & 63, w = F.wave;
    LAS unsigned char* L = F.lds; LAS float* as_ = (LAS float*)(L + MC_AS); LAS float* dt_ = (LAS float*)(L + MC_DT); LAS float* ea_ = (LAS float*)(L + MC_EA);
    LAS float* cbr = (LAS float*)(L + MC_CBR);
    const bf16* Bx = (const bf16*)scr_f(F, S_BX); const bf16* BB = (const bf16*)scr_f(F, S_BB); const bf16* BC = (const bf16*)scr_f(F, S_BC); const float* sm = scr_f(F, S_SMALL);
    const bf16* Sb = (const bf16*)scr_f(F, S_BS); float* By = scr_f(F, S_BY);
    for (int u = F.bid; u < NCHUNK * 2; u += F.G) {
        const int c = u >> 1, g = u & 1; const size_t t0 = (size_t)c * 64;
        unsigned xpk[2][16];
#pragma unroll
        for (int q = 0; q < 2; ++q) { const bf16* xp = Bx + (t0 + (tid >> 8) * 32) * 1024 + g * 512 + q * 256 + (tid & 255);
#pragma unroll
            for (int i = 0; i < 16; ++i) xpk[q][i] = (unsigned)xp[(size_t)(2 * i) * 1024] | ((unsigned)xp[(size_t)(2 * i + 1) * 1024] << 16); }
        { const int h = g * 8 + w; const float a = wave_incl_scan(sm[SM_DA + (t0 + lane) * 16 + h], lane);
          as_[w * 64 + lane] = a; dt_[w * 64 + lane] = sm[SM_DT + (t0 + lane) * 16 + h]; ea_[w * 64 + lane] = __expf(a); }
        { const int n = tid & 127, seg = tid >> 7; const bf16* cp = BC + (t0 + seg * 16) * 256 + g * 128 + n; const bf16* bp = BB + (t0 + seg * 16) * 256 + g * 128 + n;
#pragma unroll
          for (int i = 0; i < 16; ++i) { const int t = seg * 16 + i;
              *(LAS bf16*)(L + MC_CI + t * 272 + n * 2) = cp[(size_t)i * 256]; *(LAS bf16*)(L + MC_BI + t * 272 + n * 2) = bp[(size_t)i * 256]; } }
        __syncthreads();
        if (w < 4) { const int ti = w >> 1, sj = w & 1; f32x16 acc = zero16();
            if (sj <= ti) mma32(acc, L + MC_CI + ti * 32 * 272, 272, L + MC_BI + sj * 32 * 272, 272, 8, lane);
#pragma unroll
            for (int i = 0; i < 16; ++i) cbr[(w * 64 + lane) * 16 + i] = acc[i]; }
#pragma unroll
        for (int q = 0; q < 2; ++q) {
            { const int ch = tid & 255, half = tid >> 8;
#pragma unroll
              for (int tb = 0; tb < 4; ++tb) *(LAS v4u*)(L + MC_XT + (ch >> 6) * 9216 + (ch & 63) * 144 + half * 64 + tb * 16) = (v4u){xpk[q][4 * tb], xpk[q][4 * tb + 1], xpk[q][4 * tb + 2], xpk[q][4 * tb + 3]}; }
            __syncthreads();
            const int hl = w & 3, r = q * 4 + hl, ti = w >> 2, h = g * 8 + r;
#pragma unroll
            for (int sj = 0; sj < 2; ++sj) { const int s = sj * 32 + (lane & 31); const float a_s = as_[r * 64 + s], dt_s = dt_[r * 64 + s];
#pragma unroll
                for (int i = 0; i < 16; ++i) { const int t = ti * 32 + ACC_ROW(i, lane); float val = 0.f;
                    if (sj <= ti && s <= t) val = cbr[((ti * 2 + sj) * 64 + lane) * 16 + i] * __expf(as_[r * 64 + t] - a_s) * dt_s;
                    *(LAS bf16*)(L + MC_SCI + hl * 9216 + t * 144 + s * 2) = (bf16)f2bf(val); } }
            LDS_WAIT();
#pragma unroll
            for (int pj = 0; pj < 2; ++pj) { f32x16 ai = zero16(), ae = zero16();
                mma32(ai, L + MC_SCI + hl * 9216 + ti * 32 * 144, 144, L + MC_XT + hl * 9216 + pj * 32 * 144, 144, 4, lane);
                mma32_gb<8>(ae, L + MC_CI + ti * 32 * 272, 272, (const unsigned char*)(Sb + (((size_t)c * 16 + h) * 64 + pj * 32) * 128), 256, lane);
                float* yp = By + (t0 + ti * 32) * 1024 + h * 64 + pj * 32 + (lane & 31);
#pragma unroll
                for (int i = 0; i < 16; ++i) { const int tr = ACC_ROW(i, lane); yp[(size_t)tr * 1024] = ai[i] + ea_[r * 64 + ti * 32 + tr] * ae[i]; } }
            __syncthreads();
        }
    }
}

constexpr int LA_VT = 0, LA_KT = 41472, LA_WS = 59904;
constexpr int LC_QI = 0, LC_QR = 17408, LC_KI = 34816, LC_VT = 52224, LC_PM = 93696, LC_ROWF = 102912, LC_COLF = 103168, LC_WI = 103424;
constexpr size_t OSM_BL = 4096, OSM_ML = 8192, OSM_MC = 12288;
constexpr size_t SM_EM = 3 * MiB / 4;
constexpr int ML_ROWS = 288;

__device__ __forceinline__ float wave_incl_scan_max(float x, int lane) {
    int lo = lane; asm volatile("" : "+v"(lo));
#pragma unroll
    for (int o = 1; o < 64; o <<= 1) { const float y = shfl_up_f(x, o, lo); if (lane >= o) x = fmaxf(x, y); }
    return x;
}
__device__ __forceinline__ float wave_max(float v) {
    v = fmaxf(v, xshfl<1>(v)); v = fmaxf(v, xshfl<2>(v)); v = fmaxf(v, xshfl<4>(v)); v = fmaxf(v, xshfl<8>(v)); v = fmaxf(v, xshfl<16>(v)); v = fmaxf(v, xshfl<32>(v));
    return v;
}
__device__ __forceinline__ void ml_vt_load(const bf16* P, unsigned (&pk)[16], size_t t0, int h, int tid) {
    const int v = tid & 255, half = tid >> 8; const bf16* vp = P + (t0 + half * 32) * LDP + MLC_V + h * 256 + v;
#pragma unroll
    for (int i = 0; i < 16; ++i) pk[i] = (unsigned)vp[(size_t)(2 * i) * LDP] | ((unsigned)vp[(size_t)(2 * i + 1) * LDP] << 16);
}
__device__ __forceinline__ void ml_vt_store(LAS unsigned char* VT, const unsigned (&pk)[16], int tid) {
    const int v = tid & 255, half = tid >> 8;
#pragma unroll
    for (int tb = 0; tb < 4; ++tb) *(LAS v4u*)(VT + v * 144 + half * 64 + tb * 16) = (v4u){pk[4 * tb], pk[4 * tb + 1], pk[4 * tb + 2], pk[4 * tb + 3]};
    if (tid < 32) { const unsigned one2 = (tid == 0) ? 0x3F803F80u : 0u;
#pragma unroll
        for (int i = 0; i < 8; ++i) *(LAS v4u*)(VT + (256 + tid) * 144 + i * 16) = (v4u){one2, one2, one2, one2}; }
}
__device__ __forceinline__ void ml_phase_a(Frame& F) {
    int tid = F.tid; OPAQUE_V(tid);
    const int lane = tid & 63, w = F.wave;
    LAS unsigned char* L = F.lds; LAS float* ws_ = (LAS float*)(L + LA_WS);
    const bf16* Mk = (const bf16*)scr_f(F, S_MK); const float* sm = scr_f(F, S_SMALL); const bf16* P = ws_bf(F, WS_P);
    float* U = scr_f(F, S_U); float* osm = scr_f(F, S_OSM);
    for (int u = F.bid; u < NCHUNK * 4; u += F.G) {
        const int c = u >> 2, h = u & 3; const size_t t0 = (size_t)c * 64;
        unsigned vpk[16]; bf16 kraw[16];
        ml_vt_load(P, vpk, t0, h, tid);
        { const bf16* kp = Mk + (t0 + (tid >> 7) * 16) * 512 + h * 128 + (tid & 127);
#pragma unroll
          for (int i = 0; i < 16; ++i) kraw[i] = kp[(size_t)i * 512]; }
        if (w == 0) { const float lf = sm[SM_F + (t0 + lane) * 4 + h], ip = sm[SM_EI + (t0 + lane) * 4 + h];
            const float bc = wave_incl_scan(lf, lane); const float bl = readlane_f(bc, 63); const float src = bl - bc + ip; const float ml = wave_max(src);
            ws_[lane] = __expf(src - ml);
            if (lane == 0) { osm[OSM_BL + u] = bl; osm[OSM_ML + u] = ml; } }
        __syncthreads();
        { const int d = tid & 127, seg = tid >> 7; unsigned pk[8];
#pragma unroll
          for (int i = 0; i < 8; ++i) pk[i] = pk2(bf2f(kraw[2 * i]) * ws_[seg * 16 + 2 * i], bf2f(kraw[2 * i + 1]) * ws_[seg * 16 + 2 * i + 1]);
          LAS v4u* dst = (LAS v4u*)(L + LA_KT + d * 144 + seg * 32); dst[0] = (v4u){pk[0], pk[1], pk[2], pk[3]}; dst[1] = (v4u){pk[4], pk[5], pk[6], pk[7]}; }
        ml_vt_store(L + LA_VT, vpk, tid);
        __syncthreads();
        for (int idx = w; idx < 36; idx += 8) { const int vi = idx >> 2, dj = idx & 3; f32x16 acc = zero16();
            mma32(acc, L + LA_VT + vi * 32 * 144, 144, L + LA_KT + dj * 32 * 144, 144, 4, lane);
            float* up = U + ((size_t)u * ML_ROWS + vi * 32) * 128 + dj * 32 + (lane & 31);
#pragma unroll
            for (int i = 0; i < 16; ++i) up[(size_t)ACC_ROW(i, lane) * 128] = acc[i]; }
        __syncthreads();
    }
}
__device__ __forceinline__ void ml_phase_b(Frame& F) {
    int tid = F.tid; OPAQUE_V(tid);
    const float* U = scr_f(F, S_U); float* osm = scr_f(F, S_OSM); bf16* Sb = (bf16*)scr_f(F, S_MS);
    for (int e = F.bid * NTHREADS + tid; e < 4 * ML_ROWS * 128; e += F.G * NTHREADS) {
        const int h = e / (ML_ROWS * 128), vd = e % (ML_ROWS * 128); float S = 0.f, m = 0.f;
        for (int c0 = 0; c0 < NCHUNK; c0 += 8) { float uv[8], bl[8], ml[8];
#pragma unroll
            for (int i = 0; i < 8; ++i) { const size_t un = (size_t)(c0 + i) * 4 + h; uv[i] = U[un * (ML_ROWS * 128) + vd]; bl[i] = osm[OSM_BL + un]; ml[i] = osm[OSM_ML + un]; }
#pragma unroll
            for (int i = 0; i < 8; ++i) { const size_t un = (size_t)(c0 + i) * 4 + h; Sb[un * (ML_ROWS * 128) + vd] = (bf16)f2bf(S); if (vd == 0) osm[OSM_MC + un] = m;
                const float mn = fmaxf(bl[i] + m, ml[i]); S = __expf(bl[i] + m - mn) * S + __expf(ml[i] - mn) * uv[i]; m = mn; } }
    }
}
__device__ __forceinline__ void ml_phase_c(Frame& F) {
    int tid = F.tid; OPAQUE_V(tid);
    const int lane = tid & 63, w = F.wave;
    LAS unsigned char* L = F.lds; LAS float* rowf = (LAS float*)(L + LC_ROWF); LAS float* colf = (LAS float*)(L + LC_COLF); LAS float* wi_ = (LAS float*)(L + LC_WI);
    const bf16* Mq = (const bf16*)scr_f(F, S_MQ); const bf16* Mk = (const bf16*)scr_f(F, S_MK); float* sm = scr_f(F, S_SMALL); const bf16* P = ws_bf(F, WS_P);
    const float* osm = scr_f(F, S_OSM); const bf16* Sb = (const bf16*)scr_f(F, S_MS); float* Mnum = scr_f(F, S_MNUM);
    for (int u = F.bid; u < NCHUNK * 4; u += F.G) {
        const int c = u >> 2, h = u & 3; const size_t t0 = (size_t)c * 64;
        unsigned vpk[16]; bf16 qraw[16], kraw[16];
        ml_vt_load(P, vpk, t0, h, tid);
        { const bf16* qp = Mq + (t0 + (tid >> 7) * 16) * 512 + h * 128 + (tid & 127); const bf16* kp = Mk + (t0 + (tid >> 7) * 16) * 512 + h * 128 + (tid & 127);
#pragma unroll
          for (int i = 0; i < 16; ++i) { qraw[i] = qp[(size_t)i * 512]; kraw[i] = kp[(size_t)i * 512]; } }
        if (w == 0) { const float lf = sm[SM_F + (t0 + lane) * 4 + h], ip = sm[SM_EI + (t0 + lane) * 4 + h];
            const float bc = wave_incl_scan(lf, lane); const float us = ip - bc; const float pm = wave_incl_scan_max(us, lane); const float mc = osm[OSM_MC + u];
            const float mt = bc + fmaxf(mc, pm);
            rowf[lane] = bc - mt; colf[lane] = us; wi_[lane] = __expf(bc + mc - mt);
            sm[SM_EM + (t0 + lane) * 4 + h] = __expf(-mt); }
        __syncthreads();
        { const int d = tid & 127, seg = tid >> 7;
#pragma unroll
          for (int i = 0; i < 16; ++i) { const int t = seg * 16 + i; const float q = bf2f(qraw[i]);
              *(LAS bf16*)(L + LC_QR + t * 272 + d * 2) = (bf16)f2bf(q); *(LAS bf16*)(L + LC_QI + t * 272 + d * 2) = (bf16)f2bf(q * wi_[t]);
              *(LAS bf16*)(L + LC_KI + t * 272 + d * 2) = kraw[i]; } }
        ml_vt_store(L + LC_VT, vpk, tid);
        __syncthreads();
        if (w < 4) { const int ti = w >> 1, sj = w & 1; f32x16 acc = zero16();
            if (sj <= ti) mma32(acc, L + LC_QR + ti * 32 * 272, 272, L + LC_KI + sj * 32 * 272, 272, 8, lane);
            const int s = sj * 32 + (lane & 31); const float cf = colf[s];
#pragma unroll
            for (int i = 0; i < 16; ++i) { const int t = ti * 32 + ACC_ROW(i, lane); *(LAS bf16*)(L + LC_PM + t * 144 + s * 2) = (bf16)f2bf(s <= t ? acc[i] * __expf(fminf(rowf[t] + cf, 0.f)) : 0.f); } }
        __syncthreads();
        for (int idx = w; idx < 18; idx += 8) { const int ti = idx / 9, vj = idx % 9; f32x16 acc = zero16();
            mma32_gb<8>(acc, L + LC_QI + ti * 32 * 272, 272, (const unsigned char*)(Sb + ((size_t)u * ML_ROWS + vj * 32) * 128), 256, lane);
            mma32(acc, L + LC_PM + ti * 32 * 144, 144, L + LC_VT + vj * 32 * 144, 144, 4, lane);
            if (vj < 8) { float* op = Mnum + (t0 + ti * 32) * 1024 + h * 256 + vj * 32 + (lane & 31);
#pragma unroll
                for (int i = 0; i < 16; ++i) op[(size_t)ACC_ROW(i, lane) * 1024] = acc[i]; }
            else if ((lane & 31) == 0) {
#pragma unroll
                for (int i = 0; i < 16; ++i) sm[SM_DEN + (t0 + ti * 32 + ACC_ROW(i, lane)) * 4 + h] = acc[i]; } }
        __syncthreads();
    }
}

constexpr int RIMG = 9216;
constexpr int RW_SEG = 14 * RIMG, RW_EGL = RW_SEG + 2048 - 256;
static_assert(RW_SEG + 2048 <= RING_BYTES, "RWKV LDS map");
#define RW_IMG(k) (L + (k) * RIMG)

__device__ __forceinline__ void rw_store_T(LAS unsigned char* img, const f32x16& a, int rowbase, int col, int lane) {
#pragma unroll
    for (int g = 0; g < 4; ++g) { v2u o; o.x = pk2(a[4 * g], a[4 * g + 1]); o.y = pk2(a[4 * g + 2], a[4 * g + 3]);
        *(LAS v2u*)(img + col * 144 + (rowbase + 8 * g + 4 * (lane >> 5)) * 2) = o; }
}
__device__ __forceinline__ void rw_store_N(LAS unsigned char* img, const f32x16& a, int rowbase, int col, int lane) {
#pragma unroll
    for (int i = 0; i < 16; ++i) *(LAS bf16*)(img + (rowbase + ACC_ROW(i, lane)) * 144 + col * 2) = (bf16)f2bf(a[i]);
}
__device__ __forceinline__ void rw_phase_a(Frame& F) {
    int tid = F.tid; OPAQUE_V(tid);
    const int lane = tid & 63, w = F.wave, n = lane, seg = w;
    LAS unsigned char* L = F.lds; LAS float* segtot = (LAS float*)(L + RW_SEG); LAS float* egl = (LAS float*)(L + RW_EGL);
    const bf16* Rr = (const bf16*)scr_f(F, S_RR); const _Float16* Rw = (const _Float16*)scr_f(F, S_RW); const bf16* Rk2 = (const bf16*)scr_f(F, S_RK2); const bf16* Rkk = (const bf16*)scr_f(F, S_RKK); const bf16* Rkka = (const bf16*)scr_f(F, S_RKKA); const bf16* Rv = (const bf16*)scr_f(F, S_RV);
    bf16* MQ = (bf16*)scr_f(F, S_RMQ); float* RN = scr_f(F, S_RN); float* ROL = scr_f(F, S_ROL);
    const int ti = w >> 2, cj = w & 3, cl = lane & 31;
    float lw[8]; bf16 qkk[8], qkka[8], qk2[8], qrr[8], qvv[8];
#define RW_LOAD(uu) do { const size_t rb_ = ((size_t)((uu) >> 4) * 64 + seg * 8) * 1024 + ((uu) & 15) * 64 + n; \
        _Pragma("unroll") for (int i = 0; i < 8; ++i) { const size_t o = rb_ + (size_t)i * 1024; lw[i] = (float)Rw[o]; qkk[i] = Rkk[o]; qkka[i] = Rkka[o]; qk2[i] = Rk2[o]; qrr[i] = Rr[o]; qvv[i] = Rv[o]; } } while (0)
    if (F.bid < NCHUNK * 16) RW_LOAD(F.bid);
    for (int u = F.bid; u < NCHUNK * 16; u += F.G) {
        float r[8];
        { float run = 0.f;
#pragma unroll
            for (int i = 0; i < 8; ++i) { run += lw[i]; r[i] = run; }
            segtot[seg * 64 + n] = run; }
        __syncthreads();
        float off = 0.f, tot = 0.f;
#pragma unroll
        for (int s = 0; s < 8; ++s) { const float sv = segtot[s * 64 + n]; tot += sv; if (s < seg) off += sv; }
        { unsigned bh[4], kh[4], vt[4];
#pragma unroll
          for (int i = 0; i < 8; i += 2) { float bhv[2], khv[2], vv[2];
#pragma unroll
              for (int e = 0; e < 2; ++e) { const int ii = i + e, t = seg * 8 + ii;
                  const float cum = off + r[ii], cp = cum - lw[ii]; const float kk = bf2f(qkk[ii]), kka = bf2f(qkka[ii]), k2 = bf2f(qk2[ii]), rr = bf2f(qrr[ii]);
                  const float eneg = __expf(-cum), eh = __expf(tot - cum);
                  *(LAS bf16*)(RW_IMG(0) + t * 144 + n * 2) = (bf16)f2bf(-kk * __expf(cp));
                  *(LAS bf16*)(RW_IMG(1) + t * 144 + n * 2) = (bf16)f2bf(rr * __expf(cum));
                  *(LAS bf16*)(RW_IMG(2) + t * 144 + n * 2) = (bf16)f2bf(kka * eneg);
                  *(LAS bf16*)(RW_IMG(3) + t * 144 + n * 2) = (bf16)f2bf(k2 * eneg);
                  bhv[e] = kka * eh; khv[e] = k2 * eh; vv[e] = bf2f(qvv[ii]); }
              bh[i >> 1] = pk2(bhv[0], bhv[1]); kh[i >> 1] = pk2(khv[0], khv[1]); vt[i >> 1] = pk2(vv[0], vv[1]); }
          *(LAS v4u*)(RW_IMG(4) + n * 144 + seg * 16) = (v4u){bh[0], bh[1], bh[2], bh[3]};
          *(LAS v4u*)(RW_IMG(5) + n * 144 + seg * 16) = (v4u){kh[0], kh[1], kh[2], kh[3]};
          *(LAS v4u*)(RW_IMG(6) + n * 144 + seg * 16) = (v4u){vt[0], vt[1], vt[2], vt[3]}; }
        if (u + F.G < NCHUNK * 16) RW_LOAD(u + F.G);
        __syncthreads();
        if (seg == 7) egl[n] = __expf(tot);
        { const int pidx = w >> 1, sj = w & 1; LAS unsigned char* Ai = (pidx < 2) ? RW_IMG(0) : RW_IMG(1); LAS unsigned char* Bi = (pidx & 1) ? RW_IMG(3) : RW_IMG(2);
          LAS unsigned char* dst = pidx == 0 ? RW_IMG(7) : (pidx == 1 ? RW_IMG(9) : (pidx == 2 ? RW_IMG(10) : RW_IMG(11)));
#pragma unroll
          for (int t2 = 0; t2 < 2; ++t2) { f32x16 acc = zero16();
              if (sj <= t2) mma32(acc, Ai + t2 * 32 * 144, 144, Bi + sj * 32 * 144, 144, 4, lane);
              const int s = sj * 32 + cl;
#pragma unroll
              for (int i = 0; i < 16; ++i) { const int t = t2 * 32 + ACC_ROW(i, lane); const bool keep = (pidx < 2) ? (s < t) : (s <= t); acc[i] = keep ? acc[i] : 0.f; }
              rw_store_N(dst, acc, t2 * 32, s, lane);
              if (pidx == 0) rw_store_T(RW_IMG(8), acc, t2 * 32, s, lane); } }
        __syncthreads();
        f32x16 X;
        if (cj < 2) {
#pragma unroll
            for (int i = 0; i < 16; ++i) X[i] = bf2f(*(const LAS bf16*)(RW_IMG(0) + (ti * 32 + ACC_ROW(i, lane)) * 144 + (cj * 32 + cl) * 2));
        } else { X = zero16(); mma32(X, RW_IMG(9) + ti * 32 * 144, 144, RW_IMG(6) + (cj - 2) * 32 * 144, 144, 4, lane); }
        rw_store_T(RW_IMG(2), X, ti * 32, cj * 32 + cl, lane);
        __syncthreads();
#pragma unroll
        for (int st = 0; st < 6; ++st) {
            LAS unsigned char* Pc = (st & 1) ? RW_IMG(0) : RW_IMG(7); LAS unsigned char* PTc = (st & 1) ? RW_IMG(9) : RW_IMG(8); LAS unsigned char* XTc = (st & 1) ? RW_IMG(12) : RW_IMG(2);
            LAS unsigned char* Pn = (st & 1) ? RW_IMG(7) : RW_IMG(0); LAS unsigned char* PTn = (st & 1) ? RW_IMG(8) : RW_IMG(9); LAS unsigned char* XTn = (st & 1) ? RW_IMG(2) : RW_IMG(12);
            mma32(X, Pc + ti * 32 * 144, 144, XTc + cj * 32 * 144, 144, 4, lane);
            if (st < 5 && cj < 2) { f32x16 sq = zero16(); mma32(sq, Pc + ti * 32 * 144, 144, PTc + cj * 32 * 144, 144, 4, lane);
                rw_store_N(Pn, sq, ti * 32, cj * 32 + cl, lane); rw_store_T(PTn, sq, ti * 32, cj * 32 + cl, lane); }
            rw_store_T(XTn, X, ti * 32, cj * 32 + cl, lane);
            __syncthreads();
        }
        { f32x16 acc = zero16();
          mma32(acc, RW_IMG(4) + ti * 32 * 144, 144, RW_IMG(2) + cj * 32 * 144, 144, 4, lane);
          if (cj >= 2) mma32(acc, RW_IMG(5) + ti * 32 * 144, 144, RW_IMG(6) + (cj - 2) * 32 * 144, 144, 4, lane);
          if (cj < 2) { bf16* mt = MQ + (size_t)u * 8192;
#pragma unroll
              for (int i = 0; i < 16; ++i) { const int k = ti * 32 + ACC_ROW(i, lane), kp = cj * 32 + cl; const float val = acc[i] + (k == kp ? egl[k] : 0.f); mt[k * 64 + kp] = (bf16)f2bf(val); } }
          else { float* nt = RN + (size_t)u * 4096 + (ti * 2 + (cj - 2)) * 1024;
#pragma unroll
              for (int q4 = 0; q4 < 4; ++q4) *(f32x4*)(nt + (q4 * 64 + lane) * 4) = (f32x4){acc[4 * q4], acc[4 * q4 + 1], acc[4 * q4 + 2], acc[4 * q4 + 3]}; } }
        { f32x16 acc;
          if (cj < 2) {
#pragma unroll
              for (int i = 0; i < 16; ++i) acc[i] = bf2f(*(const LAS bf16*)(RW_IMG(1) + (ti * 32 + ACC_ROW(i, lane)) * 144 + (cj * 32 + cl) * 2));
          } else acc = zero16();
          mma32(acc, RW_IMG(10) + ti * 32 * 144, 144, RW_IMG(2) + cj * 32 * 144, 144, 4, lane);
          if (cj >= 2) mma32(acc, RW_IMG(11) + ti * 32 * 144, 144, RW_IMG(6) + (cj - 2) * 32 * 144, 144, 4, lane);
          if (cj < 2) { bf16* qe = MQ + (size_t)u * 8192 + 4096;
#pragma unroll
              for (int i = 0; i < 16; ++i) qe[(ti * 32 + ACC_ROW(i, lane)) * 64 + cj * 32 + cl] = (bf16)f2bf(acc[i]); }
          else { float* ol = ROL + (size_t)u * 4096;
#pragma unroll
              for (int i = 0; i < 16; ++i) ol[(ti * 32 + ACC_ROW(i, lane)) * 64 + (cj - 2) * 32 + cl] = acc[i]; } }
        __syncthreads();
    }
#undef RW_LOAD
}
constexpr int RB_SLOT = 16384, RB_N = 8192;
__device__ __forceinline__ void rw_phase_b(Frame& F) {
    if (F.bid >= 32) return;
    int lane = F.lane; OPAQUE_V(lane);
    const int w = F.wave, head = F.bid >> 1, vh = F.bid & 1, cl = lane & 31, hh = lane >> 5;
    LAS unsigned char* L = F.lds;
    const bf16* MQ = (const bf16*)scr_f(F, S_RMQ); const float* RN = scr_f(F, S_RN); bf16* RS = (bf16*)scr_f(F, S_RS);
    f32x16 X[2]; X[0] = zero16(); X[1] = zero16();
    v4u rmA[8], rmB[8]; f32x4 rnA[8], rnB[8];
    constexpr int NR = (NCHUNK + 6) / 7;
#define RB_LOAD(r, RM, RN_) do { const int c_ = 7 * (r) + w - 1; if ((r) < NR && w > 0 && c_ < NCHUNK) { const size_t u_ = (size_t)c_ * 16 + head; \
        _Pragma("unroll") for (int i = 0; i < 8; ++i) { const int p = lane + 64 * i; RM[i] = *(const v4u*)(MQ + u_ * 8192 + (p >> 3) * 64 + (p & 7) * 8); \
            RN_[i] = *(const f32x4*)(RN + u_ * 4096 + ((i >> 2) * 2 + vh) * 1024 + ((i & 3) * 64 + lane) * 4); } } } while (0)
#define RB_PUT(r, RM, RN_) do { const int c_ = 7 * (r) + w - 1; if ((r) < NR && w > 0 && c_ < NCHUNK) { LAS unsigned char* sl = L + (w - 1) * RB_SLOT; \
        _Pragma("unroll") for (int i = 0; i < 8; ++i) { const int p = lane + 64 * i, k = p >> 3, q8 = p & 7; \
            LAS unsigned char* fb = sl + ((((((k >> 5) * 2 + (q8 >> 2)) * 2 + ((q8 >> 1) & 1)) * 2) * 32 + (k & 31)) * 16) + (q8 & 1) * 8;     \
            *(LAS v2u*)fb = (v2u){RM[i].x, RM[i].y}; *(LAS v2u*)(fb + 512) = (v2u){RM[i].z, RM[i].w}; \
            *(LAS f32x4*)(sl + RB_N + (i * 64 + lane) * 16) = RN_[i]; } } } while (0)
#define RB_COMPUTE(r) do { if ((r) < NR && w == 0) { \
            for (int sidx = 0; sidx < 7; ++sidx) { const int c = 7 * (r) + sidx; if (c >= NCHUNK) break; \
                const size_t u = (size_t)c * 16 + head; const LAS unsigned char* sl = L + sidx * RB_SLOT; \
                bf16x8v b[2][2]; \
                _Pragma("unroll") for (int kt = 0; kt < 2; ++kt) { unsigned pq[8]; \
                    _Pragma("unroll") for (int m = 0; m < 8; ++m) pq[m] = pk2(X[kt][2 * m], X[kt][2 * m + 1]); \
                    _Pragma("unroll") for (int g = 0; g < 4; ++g) *(v2u*)(RS + u * 4096 + (vh * 32 + cl) * 64 + kt * 32 + 8 * g + 4 * hh) = (v2u){pq[2 * g], pq[2 * g + 1]}; \
                    _Pragma("unroll") for (int s2 = 0; s2 < 2; ++s2) { const v4u q = (v4u){pq[4 * s2], pq[4 * s2 + 1], pq[4 * s2 + 2], pq[4 * s2 + 3]}; b[kt][s2] = __builtin_bit_cast(bf16x8v, q); } } \
                _Pragma("unroll") for (int ko = 0; ko < 2; ++ko) { f32x16 y; \
                    _Pragma("unroll") for (int q4 = 0; q4 < 4; ++q4) { const f32x4 nv = *(const LAS f32x4*)(sl + RB_N + ((ko * 4 + q4) * 64 + lane) * 16); y[4 * q4] = nv[0]; y[4 * q4 + 1] = nv[1]; y[4 * q4 + 2] = nv[2]; y[4 * q4 + 3] = nv[3]; } \
                    _Pragma("unroll") for (int kt = 0; kt < 2; ++kt) \
                        _Pragma("unroll") for (int s2 = 0; s2 < 2; ++s2) { const bf16x8v a = *(const LAS bf16x8v*)(sl + (((((ko * 2 + kt) * 2 + s2) * 2 + hh) * 32 + cl) * 16)); \
                            y = __builtin_amdgcn_mfma_f32_32x32x16_bf16(a, b[kt][s2], y, 0, 0, 0); } \
                    X[ko] = y; } } } } while (0)
    RB_LOAD(0, rmA, rnA); RB_PUT(0, rmA, rnA);
    lds_barrier();
    RB_LOAD(1, rmA, rnA); RB_LOAD(2, rmB, rnB);
    for (int r = 0; r < NR; r += 2) {
        RB_COMPUTE(r);
        lds_barrier();
        RB_PUT(r + 1, rmA, rnA);
        lds_barrier();
        RB_LOAD(r + 3, rmA, rnA);
        RB_COMPUTE(r + 1);
        lds_barrier();
        RB_PUT(r + 2, rmB, rnB);
        lds_barrier();
        RB_LOAD(r + 4, rmB, rnB);
    }
#undef RB_COMPUTE
#undef RB_LOAD
#undef RB_PUT
}
__device__ __forceinline__ void rw_phase_c(Frame& F) {
    int lane = F.lane; OPAQUE_V(lane);
    const int w = F.wave, cl = lane & 31, hh = lane >> 5, ti = (w >> 1) & 1, vj = w & 1;
    const bf16* MQ = (const bf16*)scr_f(F, S_RMQ); const float* ROL = scr_f(F, S_ROL); const bf16* RS = (const bf16*)scr_f(F, S_RS); float* Ro = scr_f(F, S_RO);
    for (int ub = F.bid * 2; ub < NCHUNK * 16; ub += F.G * 2) {
        const int u = ub + (w >> 2), c = u >> 4, h = u & 15;
        f32x16 acc;
#pragma unroll
        for (int i = 0; i < 16; ++i) acc[i] = ROL[(size_t)u * 4096 + (ti * 32 + ACC_ROW(i, lane)) * 64 + vj * 32 + cl];
        const bf16* ap = MQ + (size_t)u * 8192 + 4096 + (ti * 32 + cl) * 64 + 8 * hh; const bf16* bp = RS + (size_t)u * 4096 + (vj * 32 + cl) * 64 + 8 * hh;
#pragma unroll
        for (int ks = 0; ks < 4; ++ks) { const bf16x8v a = *(const bf16x8v*)(ap + ks * 16), b = *(const bf16x8v*)(bp + ks * 16); acc = __builtin_amdgcn_mfma_f32_32x32x16_bf16(a, b, acc, 0, 0, 0); }
        float* op = Ro + ((size_t)c * 64 + ti * 32) * 1024 + h * 64 + vj * 32 + cl;
#pragma unroll
        for (int i = 0; i < 16; ++i) op[(size_t)ACC_ROW(i, lane) * 1024] = acc[i];
    }
}


__device__ __forceinline__ void odd_phase_b(Frame& F) {
    int tid = F.tid; OPAQUE_V(tid);
    const float* Um = scr_f(F, S_BU); float* osm = scr_f(F, S_OSM); bf16* Sbm = (bf16*)scr_f(F, S_BS);
    const float* U = scr_f(F, S_U); bf16* Sbl = (bf16*)scr_f(F, S_MS);
    constexpr size_t MLU = (size_t)ML_ROWS * 128;
    for (int e = F.bid * NTHREADS + tid; e < 131072; e += F.G * NTHREADS) {
        const int hb = e >> 13, pn = e & 8191;
        const int hm = e >> 15, vd = e & 32767; const bool extra = (vd >> 7) == 0; const int d = vd & 127;
        float Sb = 0.f, Sm = 0.f, Sx = 0.f, m = 0.f;
        for (int c0 = 0; c0 < NCHUNK; c0 += 16) { float ub[16], db[16], um[16], ux[16], bl[16], ml[16];
#pragma unroll
            for (int i = 0; i < 16; ++i) { const size_t ub_ = (size_t)(c0 + i) * 16 + hb, um_ = (size_t)(c0 + i) * 4 + hm;
                ub[i] = Um[ub_ * 8192 + pn]; db[i] = osm[ub_]; um[i] = U[um_ * MLU + vd]; ux[i] = extra ? U[um_ * MLU + 32768 + d] : 0.f; bl[i] = osm[OSM_BL + um_]; ml[i] = osm[OSM_ML + um_]; }
#pragma unroll
            for (int i = 0; i < 16; ++i) { const size_t ub_ = (size_t)(c0 + i) * 16 + hb, um_ = (size_t)(c0 + i) * 4 + hm;
                Sbm[ub_ * 8192 + pn] = (bf16)f2bf(Sb); Sb = db[i] * Sb + ub[i];
                Sbl[um_ * MLU + vd] = (bf16)f2bf(Sm); if (extra) Sbl[um_ * MLU + 32768 + d] = (bf16)f2bf(Sx); if (vd == 0) osm[OSM_MC + um_] = m;
                const float mn = fmaxf(bl[i] + m, ml[i]); const float cd = __expf(bl[i] + m - mn), ls = __expf(ml[i] - mn); Sm = cd * Sm + ls * um[i]; Sx = cd * Sx + ls * ux[i]; m = mn; } }
    }
}
#define RSUB(bit, stmt) do { for (int rq = 0; rq < ((((unsigned)(PROBE_REP)) >> (bit)) & 1u ? 2 : 1); ++rq) { __syncthreads(); stmt; } } while (0)
#define MIX_EVEN_A RSUB(16, hg_phase_a(F)); RSUB(17, rw_phase_a(F));
#define MIX_EVEN_B RSUB(18, rw_phase_b(F)); RSUB(19, hg_phase_b(F, F.G > 64 ? 32 : 0)); if (F.G > 64 && F.bid >= 32) cvt_until(F, args, CVT_TOTAL, 2);
#define MIX_EVEN_C RSUB(20, hg_phase_c(F)); RSUB(21, rw_phase_c(F));
#define MIX_ODD_A RSUB(22, ml_phase_a(F)); RSUB(23, mb_phase_a(F));
#define MIX_ODD_B RSUB(24, odd_phase_b(F));
#define MIX_ODD_C RSUB(25, ml_phase_c(F)); RSUB(26, mb_phase_c(F));

constexpr int NPHASE = 38;
__global__ void __launch_bounds__(NTHREADS, 2) trunk_fwd(Args args) {
    extern __shared__ __attribute__((aligned(16))) unsigned char lds[];
    Frame F;
    F.lds = (LAS unsigned char*)lds;
    F.MISC = (volatile LAS unsigned*)(F.lds + MISC_OFF);
    F.tid = threadIdx.x; F.lane = F.tid & 63; F.wave = __builtin_amdgcn_readfirstlane(F.tid >> 6);
    F.G = gridDim.x; F.bid = blockIdx.x; const int wave0 = F.wave;
    F.h = args.out; F.ws = args.ws;
    F.ctl = (gu32*)(args.ws + WS_CTL);
    for (int u = F.tid; u < (LDS_BYTES - LDSCTL_OFF) / 4; u += NTHREADS) ((LAS unsigned*)(F.lds + LDSCTL_OFF))[u] = 0u;
    __syncthreads();
    LAS float* const RTAB = (LAS float*)(F.lds + RTAB_OFF);
    const int lo = args.ph_lo, hi = args.ph_hi;
    const bool use_bar = (hi - lo) > 1;
    XcdBarrier bar; bar.bar = (unsigned*)(F.ctl + CW_BAR) + args.li * XCD_BAR_WORDS; bar.x = 0; bar.st = nullptr;
    if (use_bar) bar = xcd_barrier_post((unsigned*)(F.ctl + CW_BAR) + args.li * XCD_BAR_WORDS, F.MISC + 8);
#define LAUNDER() do { unsigned char* wsl = args.ws; asm volatile("" : "+s"(wsl)); F.ws = wsl; float* hl = args.out; asm volatile("" : "+s"(hl)); F.h = hl; int b_ = blockIdx.x, g_ = gridDim.x, w_ = wave0; asm volatile("" : "+s"(b_), "+s"(g_), "+s"(w_)); F.bid = b_; F.G = g_; F.wave = w_; int t_ = threadIdx.x; asm volatile("" : "+v"(t_)); F.tid = t_; F.lane = t_ & 63; } while (0)
#ifndef PROBE_REP
#define PROBE_REP 0
#endif
#define NREP(k) ((((PROBE_REP) >> (k)) & 1) ? 2 : 1)
#define IN(k) (lo <= (k) && (k) < hi)
#define SEAM(k) do { if (use_bar && (k) + 1 < hi) { xcd_barrier(bar); if ((PROBE_REP >> 14) & 1) xcd_barrier(bar); } } while (0)

    if (IN(0)) { LAUNDER(); if ((PROBE_REP >> 7) & 1) { for (int pl = 0; pl < 4; ++pl) probe_read_weights(F, args, pl); } cvt_until(F, args, cvt_mark(0, 0), 1 << 30); phase_convert_lora(F, args); phase_x_init(F, F_IN(0), ws_bf(F, WS_XN), ssq_f(F, 0)); SEAM(0); }

    for (int pass2 = 0; pass2 < (((PROBE_REP) >> 13) & 1 ? 2 : 1); ++pass2) {
    if (pass2 > 0) { LAUNDER(); phase_x_init(F, F_IN(0), ws_bf(F, WS_XN), ssq_f(F, 0)); xcd_barrier(bar); }
    for (int L = 0; L < DEPTH; ++L) {
        const int pb = 1 + 9 * L, j = L >> 1; const bool odd = (L & 1) != 0;
        if (IN(pb + 0)) { LAUNDER();
            const bf16* W = odd ? ws_bf(F, WS_WINO) + (size_t)j * E_ODD_PAD * DM : ws_bf(F, WS_WINE) + (size_t)j * E_EVEN_PAD * DM;
            const int N = odd ? E_ODD_PAD : E_EVEN_PAD;
            pg8::Gemm g{ws_bf(F, WS_XN), W, SEQ, N, DM}; pg8::StaticOrder S; S.init(SEQ, N, F.G, F.bid);
            pg8::rstd_table_fill(RTAB, ssq_f(F, 2 * L), S, F.tid); pg8::EpiInProj E{ws_bf(F, WS_P), LDP, RTAB, odd ? 0 : 1, (const float*)(F.ws + WS_LB) + (size_t)L * 1024, (_Float16*)scr_f(F, S_HF), (bf16*)scr_f(F, S_HK)};
            for (int rp = 0; rp < NREP(1); ++rp) pg8::gemm_phase<pg8::EpiInProj, pg8::StaticOrder, true, true>(F.lds + RING_OFF, g, S, E);
            { const int full = ((SEQ / 256) * (N / 256)) % F.G; if (full > 0 && F.bid >= full) cvt_until(F, args, CVT_TOTAL, 5); }
            SEAM(pb + 0);
        }
        if (IN(pb + 1)) { for (int rp = 0; rp < NREP(2); ++rp) { LAUNDER(); __syncthreads(); if (odd) RSUB(28, phase_odd_pre2(F, args, L)); else RSUB(27, phase_even_pre2(F, args, L)); } SEAM(pb + 1); }
        if (IN(pb + 2)) { for (int rp = 0; rp < NREP(3); ++rp) { LAUNDER(); __syncthreads(); if (odd) { MIX_ODD_A } else { MIX_EVEN_A } } SEAM(pb + 2); }
        if (IN(pb + 3)) { for (int rp = 0; rp < NREP(4); ++rp) { LAUNDER(); __syncthreads(); if (odd) { MIX_ODD_B } else { MIX_EVEN_B } } SEAM(pb + 3); }
        if (IN(pb + 4)) { for (int rp = 0; rp < NREP(5); ++rp) { LAUNDER(); __syncthreads(); if (odd) { MIX_ODD_C } else { MIX_EVEN_C } } SEAM(pb + 4); }
        if (IN(pb + 5)) { LAUNDER(); cvt_until(F, args, cvt_mark(L, 1), 1 << 30);
            for (int rp = 0; rp < NREP(6); ++rp) { LAUNDER(); __syncthreads(); if (odd) RSUB(30, phase_odd_post2(F, args, L)); else RSUB(29, phase_even_post2(F, args, L)); } SEAM(pb + 5); }
        if (IN(pb + 6)) { LAUNDER(); cvt_until(F, args, cvt_mark(L, 2), 1 << 30);
            const bf16* W = odd ? ws_bf(F, WS_WOUTO) + (size_t)j * DM * DM : ws_bf(F, WS_WOUTE) + (size_t)j * DM * DM;
            pg8::Gemm g{ws_bf(F, WS_MIX), W, SEQ, DM, DM}; pg8::StaticOrder S; S.init(SEQ, DM, F.G, F.bid);
            if (NREP(10) == 2) { pg8::EpiBf16P Ed{ws_bf(F, WS_P), LDP, RTAB}; pg8::gemm_phase<pg8::EpiBf16P, pg8::StaticOrder, true, true>(F.lds + RING_OFF, g, S, Ed); }
            pg8::EpiResBf16 E{ws_bf(F, WS_XN), DM, ssq_f(F, 2 * L + 1)};
            pg8::gemm_phase<pg8::EpiResBf16, pg8::StaticOrder, true, true>(F.lds + RING_OFF, g, S, E);
            SEAM(pb + 6);
        }
        if (IN(pb + 7)) { LAUNDER();
            pg8::Gemm g{ws_bf(F, WS_XN), ws_bf(F, WS_WUP) + (size_t)L * 2 * DFF * DM, SEQ, 2 * DFF, DM}; pg8::StaticOrder S; S.init(SEQ, 2 * DFF, F.G, F.bid);
            pg8::rstd_table_fill(RTAB, ssq_f(F, 2 * L + 1), S, F.tid); pg8::EpiSwiGLU E{ws_bf(F, WS_ACT), DFF, RTAB};
            for (int rp = 0; rp < NREP(9); ++rp) pg8::gemm_phase<pg8::EpiSwiGLU, pg8::StaticOrder, true, true>(F.lds + RING_OFF, g, S, E);
            { const int full = ((SEQ / 256) * (2 * DFF / 256)) % F.G; if (full > 0 && F.bid >= full) cvt_until(F, args, CVT_TOTAL, 5); }
            cvt_until(F, args, L + 1 < DEPTH ? cvt_mark(L + 1, 0) : CVT_TOTAL, 1 << 30);
            SEAM(pb + 7);
        }
        if (IN(pb + 8)) { LAUNDER();
            pg8::Gemm g{ws_bf(F, WS_ACT), ws_bf(F, WS_WDN) + (size_t)L * DM * DFF, SEQ, DM, DFF}; pg8::StaticOrder S; S.init(SEQ, DM, F.G, F.bid);
            if (NREP(11) == 2) { pg8::EpiBf16P Ed{ws_bf(F, WS_P), LDP, RTAB}; pg8::gemm_phase<pg8::EpiBf16P, pg8::StaticOrder, true, true>(F.lds + RING_OFF, g, S, Ed); }
            pg8::EpiResBf16 E{ws_bf(F, WS_XN), DM, ssq_f(F, 2 * L + 2)};
            pg8::gemm_phase<pg8::EpiResBf16, pg8::StaticOrder, true, true>(F.lds + RING_OFF, g, S, E);
            SEAM(pb + 8);
        }
    }
    }
    if (IN(NPHASE - 1)) { LAUNDER(); phase_final_norm(F, F_IN(3), ssq_f(F, 8), ws_bf(F, WS_XN)); }
#undef IN
#undef SEAM
}

#ifndef MK_CUTS
#define MK_CUTS 0
#endif
extern "C" void kernel_launch(void* const* d_in, const int* in_sizes, int n_in, void* d_out, int out_size, void* d_ws, size_t ws_size, hipStream_t stream) {
    static int grid = 0;
    if (grid == 0) {
        if (n_in != 32 || in_sizes[0] != SEQ * DM || out_size != SEQ * DM || ws_size < WS_END) { fprintf(stderr, "kernel_launch: unexpected shapes (n_in %d, in0 %d, out %d, ws %zu < %zu); nothing launched\n", n_in, n_in > 0 ? in_sizes[0] : -1, out_size, ws_size, (size_t)WS_END); grid = -1; return; }
        int dev = 0, cus = 0, per_cu = 0;
        if (hipGetDevice(&dev) != hipSuccess || hipDeviceGetAttribute(&cus, hipDeviceAttributeMultiprocessorCount, dev) != hipSuccess) { grid = -1; return; }
        if (hipFuncSetAttribute((const void*)trunk_fwd, hipFuncAttributeMaxDynamicSharedMemorySize, LDS_BYTES) != hipSuccess) { fprintf(stderr, "kernel_launch: hipFuncSetAttribute failed\n"); grid = -1; return; }
        if (hipOccupancyMaxActiveBlocksPerMultiprocessor(&per_cu, (const void*)trunk_fwd, NTHREADS, LDS_BYTES) != hipSuccess || per_cu < 1) { fprintf(stderr, "kernel_launch: occupancy query reports %d\n", per_cu); }
        (void)hipGetLastError();
        grid = cus;
    }
    if (grid < 0) return;
    if (hipMemsetAsync((char*)d_ws + WS_CTL, 0, CTL_ZERO_BYTES, stream) != hipSuccess) return;
    Args a{};
    for (int i = 0; i < 32; ++i) a.in[i] = (const float*)d_in[i];
    a.out = (float*)d_out; a.ws = (unsigned char*)d_ws;
#if MK_CUTS == 1
    a.ph_lo = 0; a.ph_hi = NPHASE; a.li = 0;
    hipLaunchKernelGGL(trunk_fwd, dim3(grid), dim3(NTHREADS), LDS_BYTES, stream, a);
#else
    for (int p = 0; p < NPHASE; ++p) { a.ph_lo = p; a.ph_hi = p + 1; a.li = 0; hipLaunchKernelGGL(trunk_fwd, dim3(grid), dim3(NTHREADS), LDS_BYTES, stream, a); }
#endif
}
```

```cpp
#include <hip/hip_runtime.h>
#include <cstdio>
#include <cstdint>

template <int O> __device__ __forceinline__ float xshfl(float v) {
    if constexpr (O < 32) return __builtin_bit_cast(float, __builtin_amdgcn_ds_swizzle(__builtin_bit_cast(int, v), 0x1f | (O << 10)));
    else { int l = (int)__builtin_amdgcn_mbcnt_hi(~0u, __builtin_amdgcn_mbcnt_lo(~0u, 0u)); asm volatile("" : "+v"(l)); return __builtin_bit_cast(float, __builtin_amdgcn_ds_bpermute((l ^ 32) << 2, __builtin_bit_cast(int, v))); }
}
__device__ __forceinline__ float shfl_up_f(float v, int o, int lane_opaque) { return __builtin_bit_cast(float, __builtin_amdgcn_ds_bpermute(((lane_opaque - o) & 63) << 2, __builtin_bit_cast(int, v))); }
__device__ __forceinline__ float readlane_f(float v, int l) { return __builtin_bit_cast(float, __builtin_amdgcn_readlane(__builtin_bit_cast(int, v), l)); }
template <int CTRL> __device__ __forceinline__ float dpp_add(float v) { return v + __builtin_bit_cast(float, __builtin_amdgcn_update_dpp(0, __builtin_bit_cast(int, v), CTRL, 0xf, 0xf, false)); }
__device__ __forceinline__ float row16_sum(float v) { v = dpp_add<0xB1>(v); v = dpp_add<0x4E>(v); v = dpp_add<0x141>(v); v = dpp_add<0x140>(v); return v; }
__device__ __forceinline__ void lds_barrier() { asm volatile("s_waitcnt lgkmcnt(0)\n\ts_barrier" ::: "memory"); }
#define MK_CUTS 1
namespace pg8 {
#define PG8_LAS __attribute__((address_space(3)))
typedef unsigned short bf16_t;
typedef short bf16x8 __attribute__((ext_vector_type(8)));
typedef float f32x4 __attribute__((ext_vector_type(4)));
typedef unsigned u32x4 __attribute__((ext_vector_type(4)));
constexpr int BM = 256, BK = 64, HALF = 128, HTB = HALF * BK * 2  , STAGE_BYTES = 8 * HTB, NXCD = 8, WGM = 8;

__host__ __device__ __forceinline__ int lds_byte(int r, int c) { const int st = (r >> 4) * 2 + (c >> 5), rr = r & 15, cc = c & 31, ob = rr * 64 + cc * 2; return st * 1024 + (ob ^ (((ob >> 9) & 1) << 5)); }
__host__ __device__ __forceinline__ void stage_rc(int b, int& R, int& C) { const int st = b / 1024, sb = b % 1024, swz = sb ^ (((sb >> 9) & 1) << 5); R = (st >> 1) * 16 + swz / 64; C = (st & 1) * 32 + (swz % 64) / 2; }
__host__ __device__ __forceinline__ int perm32(int rho) { const int n = rho >> 4, i = rho & 15; return 8 * (i >> 2) + 4 * n + (i & 3); }

struct Unit { int pm, pn, idx; };
struct Gemm { const bf16_t* A; const bf16_t* Bt; int M, N, K; };

struct StaticOrder {
    int nM, nN, nwg, G, c;
    __host__ __device__ void init(int M, int N, int G_, int c_) { nM = M / BM; nN = N / BM; nwg = nM * nN; G = G_; c = c_; }
    __host__ __device__ bool next(int i, Unit& u) const {
        const long L = (long)i * G + c; if (L >= nwg) return false;
        int wgid = (int)L; { const int q = nwg / NXCD, r = nwg % NXCD, xcd = wgid % NXCD, off = wgid / NXCD; wgid = (xcd < r ? xcd * (q + 1) : r * (q + 1) + (xcd - r) * q) + off; }
        const int nig = WGM * nN, gid = wgid / nig, fm = gid * WGM, gsz = (nM - fm) < WGM ? (nM - fm) : WGM;
        u.pm = fm + ((wgid % nig) % gsz); u.pn = (wgid % nig) / gsz; return true;
    }
    __device__ __forceinline__ void a_ready(const Unit&) const {}
    __device__ __forceinline__ void done(const Unit&) const {}
};

__device__ __forceinline__ unsigned cvt_pk_bf16(float lo, float hi) { unsigned r; asm volatile("v_cvt_pk_bf16_f32 %0, %1, %2" : "=v"(r) : "v"(lo), "v"(hi)); return r; }
typedef float f32x2 __attribute__((ext_vector_type(2)));


__device__ __forceinline__ float row_rstd(const float* ssq, int row, int fq) {
    const f32x4 a = *(const f32x4*)(ssq + (size_t)row * 32 + 8 * fq), b = *(const f32x4*)(ssq + (size_t)row * 32 + 8 * fq + 4);
    float s = ((a[0] + a[1]) + (a[2] + a[3])) + ((b[0] + b[1]) + (b[2] + b[3]));
    s += xshfl<16>(s); s += xshfl<32>(s);
    return 1.0f / sqrtf(s * (1.0f / 2048.0f) + 1e-6f);
}

template <class Sched> __device__ __forceinline__ void rstd_table_fill(PG8_LAS float* rtab, const float* ssq, const Sched& S, int tid_) {
    int tid = tid_; asm volatile("" : "+v"(tid));
    Unit u;
    for (int i = 0; S.next(i, u); ++i) {
        if (tid < 256) { const float* p = ssq + ((size_t)u.pm * 256 + tid) * 32; float s = 0.f;
#pragma unroll
            for (int q = 0; q < 8; ++q) { const f32x4 a = *(const f32x4*)(p + 4 * q); s += (a[0] + a[1]) + (a[2] + a[3]); }
            rtab[i * 256 + tid] = 1.0f / sqrtf(s * (1.0f / 2048.0f) + 1e-6f); }
    }
    __syncthreads();
}
__device__ __forceinline__ float silu_f(float g) { return g * __builtin_amdgcn_rcpf(1.0f + __expf(-g)); }
struct EpiBf16P {
    static constexpr bool PERM = true, AFTER_DRAIN = false;
    bf16_t* O; int ldc; const PG8_LAS float* rtab;
    __device__ __forceinline__ void operator()(const f32x4 (&acc)[2][2][4][2], const Unit& u, int wr, int wc, int fr, int fq) const {
        const int row0 = u.pm * BM + wr * 64 + fr; const int col0 = u.pn * BM + wc * 32 + 8 * fq;
#pragma unroll
        for (int ai = 0; ai < 2; ++ai)
#pragma unroll
            for (int m = 0; m < 4; ++m) { bf16_t* rowp = O + (size_t)(row0 + ai * HALF + m * 16) * ldc + col0;
                const float rs = rtab[u.idx * 256 + wr * 64 + fr + ai * HALF + m * 16];
#pragma unroll
                for (int bj = 0; bj < 2; ++bj) { const f32x4 v0 = acc[ai][bj][m][0] * rs, v1 = acc[ai][bj][m][1] * rs;
                    u32x4 w; w.x = cvt_pk_bf16(v0[0], v0[1]); w.y = cvt_pk_bf16(v0[2], v0[3]); w.z = cvt_pk_bf16(v1[0], v1[1]); w.w = cvt_pk_bf16(v1[2], v1[3]);
                    *(u32x4*)(rowp + bj * HALF) = w; } }
    }
};
struct EpiResF32 {
    static constexpr bool PERM = false, AFTER_DRAIN = false;
    float* C; int ldc;
    __device__ __forceinline__ void operator()(const f32x4 (&acc)[2][2][4][2], const Unit& u, int wr, int wc, int fr, int fq) const {
        const int row0 = u.pm * BM + wr * 64 + fr, col0 = u.pn * BM + wc * 32 + 4 * fq;
#pragma unroll
        for (int ai = 0; ai < 2; ++ai)
#pragma unroll
            for (int m = 0; m < 4; ++m) { float* rowp = C + (size_t)(row0 + ai * HALF + m * 16) * ldc + col0;
#pragma unroll
                for (int bj = 0; bj < 2; ++bj)
#pragma unroll
                    for (int n = 0; n < 2; ++n) { f32x4* p = (f32x4*)(rowp + bj * HALF + n * 16); *p = *p + acc[ai][bj][m][n]; } }
    }
};
struct EpiSwiGLU {
    static constexpr bool PERM = true, AFTER_DRAIN = false;
    bf16_t* O; int ldc; const PG8_LAS float* rtab;
    __device__ __forceinline__ void operator()(const f32x4 (&acc)[2][2][4][2], const Unit& u, int wr, int wc, int fr, int fq) const {
        const int row0 = u.pm * BM + wr * 64 + fr; const int col0 = u.pn * HALF + wc * 32 + 8 * fq;
#pragma unroll
        for (int ai = 0; ai < 2; ++ai)
#pragma unroll
            for (int m = 0; m < 4; ++m) { bf16_t* rowp = O + (size_t)(row0 + ai * HALF + m * 16) * ldc + col0;
                const float rs = rtab[u.idx * 256 + wr * 64 + fr + ai * HALF + m * 16];
                const f32x4 g0 = acc[ai][0][m][0] * rs, g1 = acc[ai][0][m][1] * rs, u0 = acc[ai][1][m][0] * rs, u1 = acc[ai][1][m][1] * rs;
                u32x4 w;
                w.x = cvt_pk_bf16(silu_f(g0[0]) * u0[0], silu_f(g0[1]) * u0[1]); w.y = cvt_pk_bf16(silu_f(g0[2]) * u0[2], silu_f(g0[3]) * u0[3]);
                w.z = cvt_pk_bf16(silu_f(g1[0]) * u1[0], silu_f(g1[1]) * u1[1]); w.w = cvt_pk_bf16(silu_f(g1[2]) * u1[2], silu_f(g1[3]) * u1[3]);
                *(u32x4*)rowp = w; }
    }
};

struct EpiResNorm {
    static constexpr bool PERM = false, AFTER_DRAIN = false;
    float* C; int ldc; bf16_t* Hb; float* ssq_out; const float* Cin;
    __device__ __forceinline__ void operator()(const f32x4 (&acc)[2][2][4][2], const Unit& u, int wr, int wc, int fr, int fq) const {
        const int row0 = u.pm * BM + wr * 64 + fr, col0 = u.pn * BM + wc * 32 + 4 * fq;
#pragma unroll
        for (int ai = 0; ai < 2; ++ai)
#pragma unroll
            for (int m = 0; m < 4; ++m) { const int row = row0 + ai * HALF + m * 16; float* rowp = C + (size_t)row * ldc + col0; const float* rinp = Cin + (size_t)row * ldc + col0; bf16_t* hbp = Hb + (size_t)row * ldc + col0; float s = 0.f;
#pragma unroll
                for (int bj = 0; bj < 2; ++bj)
#pragma unroll
                    for (int n = 0; n < 2; ++n) { f32x4* p = (f32x4*)(rowp + bj * HALF + n * 16); const f32x4 v = *(const f32x4*)(rinp + bj * HALF + n * 16) + acc[ai][bj][m][n]; *p = v;
                        typedef unsigned u32x2 __attribute__((ext_vector_type(2))); u32x2 o; o.x = cvt_pk_bf16(v[0], v[1]); o.y = cvt_pk_bf16(v[2], v[3]); *(u32x2*)(hbp + bj * HALF + n * 16) = o;
                        s += (v[0] * v[0] + v[1] * v[1]) + (v[2] * v[2] + v[3] * v[3]); }
                s += xshfl<16>(s); s += xshfl<32>(s);
                if (fq == 0) ssq_out[(size_t)row * 32 + u.pn * 4 + wc] = s; }
    }
};

struct EpiResBf16 {
    static constexpr bool PERM = true, AFTER_DRAIN = false;
    bf16_t* Hb; int ldc; float* ssq_out;
    __device__ __forceinline__ void operator()(const f32x4 (&acc)[2][2][4][2], const Unit& u, int wr, int wc, int fr, int fq) const {
        const int row0 = u.pm * BM + wr * 64 + fr, col0 = u.pn * BM + wc * 32 + 8 * fq;
#pragma unroll
        for (int ai = 0; ai < 2; ++ai)
#pragma unroll
            for (int m = 0; m < 4; ++m) { const int row = row0 + ai * HALF + m * 16; bf16_t* hbp = Hb + (size_t)row * ldc + col0; float s = 0.f;
#pragma unroll
                for (int bj = 0; bj < 2; ++bj) { const u32x4 o = *(const u32x4*)(hbp + bj * HALF);
                    f32x4 v0 = acc[ai][bj][m][0], v1 = acc[ai][bj][m][1];
                    v0[0] += __builtin_bit_cast(float, o.x << 16); v0[1] += __builtin_bit_cast(float, o.x & 0xffff0000u); v0[2] += __builtin_bit_cast(float, o.y << 16); v0[3] += __builtin_bit_cast(float, o.y & 0xffff0000u);
                    v1[0] += __builtin_bit_cast(float, o.z << 16); v1[1] += __builtin_bit_cast(float, o.z & 0xffff0000u); v1[2] += __builtin_bit_cast(float, o.w << 16); v1[3] += __builtin_bit_cast(float, o.w & 0xffff0000u);
                    s += ((v0[0] * v0[0] + v0[1] * v0[1]) + (v0[2] * v0[2] + v0[3] * v0[3])) + ((v1[0] * v1[0] + v1[1] * v1[1]) + (v1[2] * v1[2] + v1[3] * v1[3]));
                    u32x4 w; w.x = cvt_pk_bf16(v0[0], v0[1]); w.y = cvt_pk_bf16(v0[2], v0[3]); w.z = cvt_pk_bf16(v1[0], v1[1]); w.w = cvt_pk_bf16(v1[2], v1[3]);
                    *(u32x4*)(hbp + bj * HALF) = w; }
                s += xshfl<16>(s); s += xshfl<32>(s);
                if (fq == 0) ssq_out[(size_t)row * 32 + u.pn * 4 + wc] = s; }
    }
};

struct EpiInProj {
    static constexpr bool PERM = true, AFTER_DRAIN = false;
    bf16_t* O; int ldc; const PG8_LAS float* rtab; int hg; const float* lb; _Float16* Hf; bf16_t* Hk;
    __device__ __forceinline__ void operator()(const f32x4 (&acc)[2][2][4][2], const Unit& u, int wr, int wc, int fr, int fq) const {
        const int row0 = u.pm * BM + wr * 64 + fr; const int col0 = u.pn * BM + wc * 32 + 8 * fq;
        const int mode = hg ? (u.pn < 4 ? 1 : (u.pn < 8 ? 2 : 0)) : 0;
        if (mode == 2) {
            const int cf = col0 - 1024;
            f32x4 lbv[2][2];
#pragma unroll
            for (int bj = 0; bj < 2; ++bj) { lbv[bj][0] = *(const f32x4*)(lb + cf + bj * HALF); lbv[bj][1] = *(const f32x4*)(lb + cf + bj * HALF + 4); }
#pragma unroll
            for (int ai = 0; ai < 2; ++ai)
#pragma unroll
                for (int m = 0; m < 4; ++m) { const int row = row0 + ai * HALF + m * 16; const float rs = rtab[u.idx * 256 + wr * 64 + fr + ai * HALF + m * 16];
#pragma unroll
                    for (int bj = 0; bj < 2; ++bj) { f32x4 hf[2], hk[2];
#pragma unroll
                        for (int n = 0; n < 2; ++n)
#pragma unroll
                            for (int j = 0; j < 4; ++j) { const float f = acc[ai][bj][m][n][j] * rs, l = lbv[bj][n][j]; const float ee = __expf(fminf(-f, 80.f)), sg = __builtin_amdgcn_rcpf(1.0f + ee);
                                hf[n][j] = l + (1.f - l) * sg; hk[n][j] = (1.f - l) * ee * sg; }
                        { typedef _Float16 h2 __attribute__((ext_vector_type(2))); u32x4 hw;
                          hw.x = __builtin_bit_cast(unsigned, (h2){(_Float16)hf[0][0], (_Float16)hf[0][1]}); hw.y = __builtin_bit_cast(unsigned, (h2){(_Float16)hf[0][2], (_Float16)hf[0][3]});
                          hw.z = __builtin_bit_cast(unsigned, (h2){(_Float16)hf[1][0], (_Float16)hf[1][1]}); hw.w = __builtin_bit_cast(unsigned, (h2){(_Float16)hf[1][2], (_Float16)hf[1][3]});
                          *(u32x4*)(Hf + (size_t)row * 1024 + cf + bj * HALF) = hw; }
                        u32x4 w; w.x = cvt_pk_bf16(hk[0][0], hk[0][1]); w.y = cvt_pk_bf16(hk[0][2], hk[0][3]); w.z = cvt_pk_bf16(hk[1][0], hk[1][1]); w.w = cvt_pk_bf16(hk[1][2], hk[1][3]);
                        *(u32x4*)(Hk + (size_t)row * 1024 + cf + bj * HALF) = w; } }
            return;
        }
#pragma unroll
        for (int ai = 0; ai < 2; ++ai)
#pragma unroll
            for (int m = 0; m < 4; ++m) { bf16_t* rowp = O + (size_t)(row0 + ai * HALF + m * 16) * ldc + col0;
                const float rs = rtab[u.idx * 256 + wr * 64 + fr + ai * HALF + m * 16];
#pragma unroll
                for (int bj = 0; bj < 2; ++bj) { f32x4 v0 = acc[ai][bj][m][0] * rs, v1 = acc[ai][bj][m][1] * rs;
                    if (mode == 1) {
#pragma unroll
                        for (int j = 0; j < 4; ++j) { v0[j] = silu_f(v0[j]); v1[j] = silu_f(v1[j]); } }
                    u32x4 w; w.x = cvt_pk_bf16(v0[0], v0[1]); w.y = cvt_pk_bf16(v0[2], v0[3]); w.z = cvt_pk_bf16(v1[0], v1[1]); w.w = cvt_pk_bf16(v1[2], v1[3]);
                    *(u32x4*)(rowp + bj * HALF) = w; } }
    }
};
template <class Epi, class Sched, bool ALIGN_EPI = false, bool SP2 = false>
__device__ __forceinline__ void gemm_phase(PG8_LAS unsigned char* lds, const Gemm g, const Sched& S, const Epi& E) {
    int tid_ = threadIdx.x; asm volatile("" : "+v"(tid_));
    const int tid = tid_, wid = __builtin_amdgcn_readfirstlane(tid >> 6), lane = tid & 63, wr = wid >> 2, wc = wid & 3, fr = lane & 15, fq = lane >> 4;
    const int K = g.K, nt = K / BK;
    unsigned voffA[2], voffB[2];
#pragma unroll
    for (int i = 0; i < 2; ++i) { int R, C; stage_rc(tid * 16 + i * 8192, R, C); const int Rb = Epi::PERM ? ((R & ~31) + perm32(R & 31)) : R;
        voffA[i] = (unsigned)(R * K + C) * 2u; voffB[i] = (unsigned)(Rb * K + C) * 2u; }
    const size_t kstep = (size_t)(BK * 2);
    const size_t hstep = (size_t)HALF * K * 2;
    const size_t tstep = 2 * hstep;
    const unsigned ldsw = (unsigned)wid * 1024u;
    const int aoff = lds_byte(wr * 64 + fr, fq * 8), boff = lds_byte(wc * 32 + fr, fq * 8);
#define PG8_SA(b, h) (((b) * 2 + (h)) * HTB)
#define PG8_SB(b, h) ((4 + (b) * 2 + (h)) * HTB)
#define PG8_STAGE(bufoff, gbase, voff) do { _Pragma("unroll") for (int _i = 0; _i < 2; ++_i) \
        __builtin_amdgcn_global_load_lds((const unsigned*)((const char*)(gbase) + (voff)[_i]), (PG8_LAS unsigned*)(lds + (bufoff) + ldsw + _i * 8192), 16, 0, 0); } while (0)
#define PG8_LDA(dst, b, h) do { _Pragma("unroll") for (int m = 0; m < 4; ++m) _Pragma("unroll") for (int k = 0; k < 2; ++k) dst[m][k] = *(const PG8_LAS bf16x8*)(lds + PG8_SA(b, h) + aoff + m * 2048 + k * 1024); } while (0)
#define PG8_LDB(dst, b, h) do { _Pragma("unroll") for (int n = 0; n < 2; ++n) _Pragma("unroll") for (int k = 0; k < 2; ++k) dst[n][k] = *(const PG8_LAS bf16x8*)(lds + PG8_SB(b, h) + boff + n * 2048 + k * 1024); } while (0)
#define PG8_MMA(ai, bj, At, Bt) do { __builtin_amdgcn_s_setprio(1); _Pragma("unroll") for (int m = 0; m < 4; ++m) _Pragma("unroll") for (int n = 0; n < 2; ++n) _Pragma("unroll") for (int k = 0; k < 2; ++k) \
        acc[ai][bj][m][n] = __builtin_amdgcn_mfma_f32_16x16x32_bf16(Bt[n][k], At[m][k], acc[ai][bj][m][n], 0, 0, 0); __builtin_amdgcn_s_setprio(0); } while (0)
#define PG8_WAIT_V(n) asm volatile("s_waitcnt vmcnt(" #n ")" ::: "memory")
#define PG8_WAIT_L(n) asm volatile("s_waitcnt lgkmcnt(" #n ")" ::: "memory")
#define PG8_BAR __builtin_amdgcn_s_barrier()
#define PG8_SCHED __builtin_amdgcn_sched_barrier(0)
    Unit cur, nxt; int ui = 0;
    if (!S.next(0, cur)) return;
    cur.idx = 0;
    f32x4 acc[2][2][4][2];
#pragma unroll
    for (int a = 0; a < 2; ++a)
#pragma unroll
        for (int b = 0; b < 2; ++b)
#pragma unroll
            for (int m = 0; m < 4; ++m)
#pragma unroll
                for (int n = 0; n < 2; ++n) acc[a][b][m][n] = (f32x4){0.f, 0.f, 0.f, 0.f};
    bf16x8 At[4][2], B0[2][2], B1[2][2];
    const char* cA = (const char*)g.A + (size_t)cur.pm * tstep; const char* cB = (const char*)g.Bt + (size_t)cur.pn * tstep;
    S.a_ready(cur);
    if constexpr (SP2) {
        PG8_STAGE(PG8_SB(0, 0), cB, voffB); PG8_STAGE(PG8_SB(0, 1), cB + hstep, voffB); PG8_STAGE(PG8_SA(0, 0), cA, voffA); PG8_STAGE(PG8_SA(0, 1), cA + hstep, voffA);
        if (wr == 1) PG8_BAR;
        PG8_WAIT_V(2); PG8_BAR;
        PG8_STAGE(PG8_SB(1, 0), cB + kstep, voffB); PG8_STAGE(PG8_SA(1, 0), cA + kstep, voffA); PG8_STAGE(PG8_SB(1, 1), cB + hstep + kstep, voffB);
        PG8_WAIT_V(6); PG8_BAR;
    } else {
        PG8_STAGE(PG8_SB(0, 0), cB, voffB); PG8_STAGE(PG8_SA(0, 0), cA, voffA); PG8_STAGE(PG8_SB(0, 1), cB + hstep, voffB); PG8_STAGE(PG8_SA(0, 1), cA + hstep, voffA);
        if (wr == 1) PG8_BAR;
        PG8_WAIT_V(4); PG8_BAR;
        PG8_STAGE(PG8_SB(1, 0), cB + kstep, voffB); PG8_STAGE(PG8_SA(1, 0), cA + kstep, voffA); PG8_STAGE(PG8_SB(1, 1), cB + hstep + kstep, voffB);
        PG8_WAIT_V(6); PG8_BAR;
    }
    for (;;) {
        const bool has_next = S.next(ui + 1, nxt); nxt.idx = ui + 1;
        const char* nA = has_next ? (const char*)g.A + (size_t)nxt.pm * tstep : cA; const char* nB = has_next ? (const char*)g.Bt + (size_t)nxt.pn * tstep : cB;
        for (int t = 0; t < nt; t += 2) {
            const bool last = (t == nt - 2);
            const char* a1 = cA + (size_t)(t + 1) * kstep;
            const char* a2 = last ? nA : cA + (size_t)(t + 2) * kstep; const char* b2 = last ? nB : cB + (size_t)(t + 2) * kstep;
            const char* a3 = a2 + kstep; const char* b3 = b2 + kstep;
            if (last && has_next) S.a_ready(nxt);
            if constexpr (SP2) {
            PG8_LDB(B0, 0, 0); PG8_LDB(B1, 0, 1); PG8_SCHED; PG8_LDA(At, 0, 0); PG8_STAGE(PG8_SA(1, 1), a1 + hstep, voffA);
            PG8_WAIT_V(8); PG8_WAIT_L(0); PG8_BAR; PG8_MMA(0, 0, At, B0); PG8_MMA(0, 1, At, B1); PG8_BAR; PG8_SCHED;
            PG8_LDA(At, 0, 1); PG8_STAGE(PG8_SB(0, 0), b2, voffB); PG8_STAGE(PG8_SB(0, 1), b2 + hstep, voffB); PG8_STAGE(PG8_SA(0, 0), a2, voffA);
            PG8_WAIT_V(8); PG8_WAIT_L(0); PG8_BAR; PG8_MMA(1, 0, At, B0); PG8_MMA(1, 1, At, B1); PG8_BAR; PG8_SCHED;
            PG8_LDB(B0, 1, 0); PG8_LDB(B1, 1, 1); PG8_SCHED; PG8_LDA(At, 1, 0); PG8_STAGE(PG8_SA(0, 1), a2 + hstep, voffA);
            PG8_WAIT_V(8); PG8_WAIT_L(0); PG8_BAR; PG8_MMA(0, 0, At, B0); PG8_MMA(0, 1, At, B1); PG8_BAR; PG8_SCHED;
            PG8_LDA(At, 1, 1); PG8_STAGE(PG8_SB(1, 0), b3, voffB); PG8_STAGE(PG8_SB(1, 1), b3 + hstep, voffB); PG8_STAGE(PG8_SA(1, 0), a3, voffA);
            PG8_WAIT_V(8); PG8_WAIT_L(0); PG8_BAR; PG8_MMA(1, 0, At, B0); PG8_MMA(1, 1, At, B1); PG8_BAR; PG8_SCHED;
            } else {
            PG8_LDB(B0, 0, 0); PG8_SCHED; PG8_LDA(At, 0, 0); PG8_STAGE(PG8_SA(1, 1), a1 + hstep, voffA);
            PG8_WAIT_L(8); PG8_BAR; PG8_WAIT_L(0); PG8_MMA(0, 0, At, B0); PG8_BAR; PG8_SCHED;
            PG8_LDB(B1, 0, 1); PG8_STAGE(PG8_SB(0, 0), b2, voffB);
            PG8_BAR; PG8_WAIT_L(0); PG8_MMA(0, 1, At, B1); PG8_BAR;
            PG8_LDA(At, 0, 1); PG8_STAGE(PG8_SA(0, 0), a2, voffA);
            PG8_BAR; PG8_WAIT_L(0); PG8_MMA(1, 0, At, B0); PG8_BAR; PG8_SCHED;
            PG8_STAGE(PG8_SB(0, 1), b2 + hstep, voffB);
            PG8_WAIT_V(6); PG8_BAR; PG8_MMA(1, 1, At, B1); PG8_BAR;
            PG8_LDB(B0, 1, 0); PG8_SCHED; PG8_LDA(At, 1, 0); PG8_STAGE(PG8_SA(0, 1), a2 + hstep, voffA);
            PG8_WAIT_L(8); PG8_BAR; PG8_WAIT_L(0); PG8_MMA(0, 0, At, B0); PG8_BAR; PG8_SCHED;
            PG8_LDB(B1, 1, 1); PG8_STAGE(PG8_SB(1, 0), b3, voffB);
            PG8_BAR; PG8_WAIT_L(0); PG8_MMA(0, 1, At, B1); PG8_BAR;
            PG8_LDA(At, 1, 1); PG8_STAGE(PG8_SA(1, 0), a3, voffA);
            PG8_BAR; PG8_WAIT_L(0); PG8_MMA(1, 0, At, B0); PG8_BAR; PG8_SCHED;
            PG8_STAGE(PG8_SB(1, 1), b3 + hstep, voffB);
            PG8_WAIT_V(6); PG8_BAR; PG8_MMA(1, 1, At, B1); PG8_BAR;
            }
        }
        if constexpr (ALIGN_EPI) { if (wr == 0) PG8_BAR; }
        if constexpr (!Epi::AFTER_DRAIN) { E(acc, cur, wr, wc, fr, fq); S.done(cur); }
        if (!has_next) break;
#pragma unroll
        for (int a = 0; a < 2; ++a)
#pragma unroll
            for (int b = 0; b < 2; ++b)
#pragma unroll
                for (int m = 0; m < 4; ++m)
#pragma unroll
                    for (int n = 0; n < 2; ++n) acc[a][b][m][n] = (f32x4){0.f, 0.f, 0.f, 0.f};
        cur = nxt; cA = nA; cB = nB; ++ui;
        if constexpr (ALIGN_EPI) { if (wr == 1) PG8_BAR; }
    }
    PG8_WAIT_V(0);
    if constexpr (!ALIGN_EPI) { if (wr == 0) PG8_BAR; }
    PG8_BAR;
    if constexpr (Epi::AFTER_DRAIN) { E.fused(acc, cur, wr, wc, fr, fq, lds, wid, lane); S.done(cur); }
#undef PG8_SA
#undef PG8_SB
#undef PG8_STAGE
#undef PG8_LDA
#undef PG8_LDB
#undef PG8_MMA
#undef PG8_WAIT_V
#undef PG8_WAIT_L
#undef PG8_BAR
#undef PG8_SCHED
}
}

constexpr int SEQ = 8192, DM = 2048, DEPTH = 4, DFF = 5632;
constexpr int E_EVEN = 7456, E_EVEN_PAD = 7680, E_ODD = 5656, E_ODD_PAD = 5888, LDP = 7680;
constexpr float EPS = 1e-6f;
constexpr int NWAVES = 8, NTHREADS = 512;
constexpr int HGC_Q = 0, HGC_F = 1024, HGC_I = 2048, HGC_G = 3072, RWC_R = 4096, RWC_K = 5120, RWC_V = 6144, RWC_WL = 7168, RWC_AL = 7232, RWC_GL = 7296;
constexpr int MLC_Q = 0, MLC_K = 512, MLC_V = 1024, MLC_I = 2048, MLC_F = 2052, MLC_O = 2056, MBC_Z = 3080, MBC_X = 4104, MBC_DT = 5640;

constexpr size_t MiB = 1u << 20;
constexpr size_t WS_CTL = 0, CTL_ZERO_BYTES = 1 * MiB;
constexpr size_t WS_WINE = 2 * MiB, WS_WOUTE = 62 * MiB, WS_WINO = 78 * MiB, WS_WOUTO = 124 * MiB, WS_WUP = 140 * MiB, WS_WDN = 316 * MiB;
constexpr size_t WS_XN = 404 * MiB, WS_P = 436 * MiB, WS_MIX = 556 * MiB, WS_ACT = 588 * MiB, WS_SCR = 676 * MiB, SCR_SLOT = 32 * MiB, WS_LORA = WS_SCR + 22 * SCR_SLOT, WS_SSQ = WS_LORA + 2 * MiB, WS_LB = WS_SSQ + 9 * MiB, WS_END = WS_LB + 1 * MiB;
constexpr size_t LORA_LAYER = 1024 * 64 + 1024 * 64 + 1024 * 160, LORA_A2 = 1024 * 64, LORA_G2 = 2 * 1024 * 64;
static_assert(WS_WINE + (size_t)2 * E_EVEN_PAD * DM * 2 <= WS_WOUTE && WS_WINO + (size_t)2 * E_ODD_PAD * DM * 2 <= WS_WOUTO && WS_WUP + (size_t)4 * 2 * DFF * DM * 2 <= WS_WDN && WS_WDN + (size_t)4 * DM * DFF * 2 <= WS_XN, "ws map (weights)");
static_assert(WS_P + (size_t)SEQ * LDP * 2 <= WS_MIX && WS_ACT + (size_t)SEQ * DFF * 2 <= WS_SCR, "ws map (activations)");
constexpr int CW_BAR = 4096;
constexpr size_t CTL_SSQ_UNUSED = 65536;

constexpr int RING_OFF = 0, RING_BYTES = 131072;
constexpr int LDSCTL_OFF = RING_BYTES, MISC_OFF = LDSCTL_OFF + 320;
constexpr int RTAB_OFF = LDSCTL_OFF + 1024;
constexpr int LDS_BYTES = 147456;

#define GAS __attribute__((address_space(1)))
#define LAS __attribute__((address_space(3)))
typedef unsigned short bf16;
typedef unsigned v4u __attribute__((ext_vector_type(4)));
typedef unsigned v2u __attribute__((ext_vector_type(2)));
typedef float f32x4 __attribute__((ext_vector_type(4)));
typedef GAS unsigned gu32;
#define RLX_AGENT __ATOMIC_RELAXED, __HIP_MEMORY_SCOPE_AGENT
#define OPAQUE_V(x) asm volatile("" : "+v"(x))
#define LDS_WAIT() asm volatile("s_waitcnt lgkmcnt(0)" ::: "memory")
#define VM_WAIT() asm volatile("s_waitcnt vmcnt(0)" ::: "memory")
typedef __bf16 hwbf16x2 __attribute__((ext_vector_type(2)));
__device__ __forceinline__ unsigned pk2(float lo, float hi) { hwbf16x2 v; v.x = (__bf16)lo; v.y = (__bf16)hi; return __builtin_bit_cast(unsigned, v); }
__device__ __forceinline__ unsigned f2bf(float f) { return (unsigned)__builtin_bit_cast(unsigned short, (__bf16)f); }
__device__ __forceinline__ float bf2f(bf16 b) { return __builtin_bit_cast(float, ((unsigned)b) << 16); }
__device__ __forceinline__ float sigmoid_f(float x) { return __builtin_amdgcn_rcpf(1.0f + __expf(-x)); }
__device__ __forceinline__ float silu_acc(float x) { return x * __builtin_amdgcn_rcpf(1.0f + __expf(-x)); }
__device__ __forceinline__ float softplus_f(float x) { return x > 20.f ? x : __logf(1.0f + __expf(x)); }
__device__ __forceinline__ float softplus_acc(float x) { if (x > 20.f) return x; const float e = __expf(x); return e < 0.02f ? e * (1.0f - e * (0.5f - e * (0.33333334f - e * 0.25f))) : __logf(1.0f + e); }
__device__ __forceinline__ float tanh_f(float x) { const float e = __expf(2.0f * fminf(fmaxf(x, -15.f), 15.f)); return (e - 1.0f) * __builtin_amdgcn_rcpf(e + 1.0f); }
__device__ __forceinline__ float wave_sum(float v) {
    v = row16_sum(v); v += xshfl<16>(v); v += xshfl<32>(v);
    return v;
}

#define XB_TMO      128
#define XB_XCNT(j)  (256  + 64 * (j))
#define XB_XSUB(j)  (1280 + 64 * (j))
#define XB_XGEN(j)  (2304 + 64 * (j))
#define XB_TOP      3328
#define XB_TOPGEN   3392
#define XCD_BAR_WORDS 3456
#define XB_SPIN_CAP (1u << 18)

__device__ __forceinline__ unsigned xb_ld(unsigned* p)              { return __hip_atomic_load(p, __ATOMIC_RELAXED, __HIP_MEMORY_SCOPE_AGENT); }
__device__ __forceinline__ unsigned xb_add(unsigned* p, unsigned v) { return __hip_atomic_fetch_add(p, v, __ATOMIC_RELAXED, __HIP_MEMORY_SCOPE_AGENT); }
__device__ __forceinline__ unsigned xb_xcc_id() { return (unsigned)__builtin_amdgcn_s_getreg((3 << 11) | 20) & 0xFu; }
#define XB_SPIN(cond, bar) do { unsigned _sp = 0; while (cond) { __builtin_amdgcn_s_sleep(1); \
    if ((++_sp & 255u) == 0u) { if (xb_ld(&(bar)[XB_TMO])) break; if (_sp > XB_SPIN_CAP) { atomicAdd(&(bar)[XB_TMO], 1u); break; } } } } while (0)

struct XcdBarrier {
    unsigned* bar; unsigned x;
    volatile LAS unsigned* st;
};
__device__ __forceinline__ XcdBarrier xcd_barrier_post(unsigned* bar, volatile LAS unsigned* st) {
    XcdBarrier b; b.bar = bar; b.x = xb_xcc_id(); b.st = st;
    if (threadIdx.x == 0) (void)xb_add(&bar[XB_XCNT(b.x)], 1u);
    return b;
}
__device__ __forceinline__ void xcd_barrier_complete(unsigned* bar, unsigned x, unsigned& nloc, unsigned& nx) {
    const unsigned G = gridDim.x * gridDim.y * gridDim.z;
    unsigned sum, cnt, mine, sp = 0u;
    for (;;) {
        sum = 0u; cnt = 0u; mine = 0u;
#pragma unroll
        for (unsigned j = 0; j < 16; ++j) { const unsigned c = xb_ld(&bar[XB_XCNT(j)]); sum += c; cnt += (c > 0u) ? 1u : 0u; mine = (j == x) ? c : mine; }
        if (sum == G) break;
        __builtin_amdgcn_s_sleep(1);
        if ((++sp & 255u) == 0u) { if (xb_ld(&bar[XB_TMO])) break; if (sp > XB_SPIN_CAP) { atomicAdd(&bar[XB_TMO], 1u); break; } }
    }
    nloc = mine > 0u ? mine : 1u; nx = cnt > 0u ? cnt : 1u;
}
__device__ __forceinline__ void xcd_barrier(const XcdBarrier& b) {
    asm volatile("s_waitcnt vmcnt(0)" ::: "memory");
    __syncthreads();
    if (threadIdx.x == 0) {
        unsigned* bar = b.bar;
        __builtin_amdgcn_s_waitcnt(0);
        unsigned nloc = b.st[0], nx = b.st[1];
        if (nloc == 0u) { xcd_barrier_complete(bar, b.x, nloc, nx); b.st[0] = nloc; b.st[1] = nx; }
        const unsigned old = xb_add(&bar[XB_XSUB(b.x)], 1u);
        const unsigned gen = old / nloc;
        if (old + 1u == (gen + 1u) * nloc) {
            __builtin_amdgcn_fence(__ATOMIC_RELEASE, "agent");
            asm volatile("s_waitcnt vmcnt(0)" ::: "memory");
            const unsigned og = xb_add(&bar[XB_TOP], 1u);
            const unsigned tg = og / nx;
            if (og + 1u == (tg + 1u) * nx) xb_add(&bar[XB_TOPGEN], 1u);
            else XB_SPIN(xb_ld(&bar[XB_TOPGEN]) == tg, bar);
            __builtin_amdgcn_fence(__ATOMIC_ACQUIRE, "agent");
            xb_add(&bar[XB_XGEN(b.x)], 1u);
            asm volatile("s_waitcnt vmcnt(0)" ::: "memory");
        } else {
            XB_SPIN(xb_ld(&bar[XB_XGEN(b.x)]) == gen, bar);
            __builtin_amdgcn_fence(__ATOMIC_ACQUIRE, "agent");
            asm volatile("s_waitcnt vmcnt(0)" ::: "memory");
        }
    }
    __syncthreads();
}

struct Args { const float* in[32]; float* out; unsigned char* ws; int ph_lo, ph_hi, li, pad; };
struct Frame {
    LAS unsigned char* lds;
    volatile LAS unsigned* MISC;
    gu32* ctl;
    int tid, lane, wave, G, bid;
    float* h;
    unsigned char* ws;
};
#define F_IN(i) (args.in[i])
__device__ __forceinline__ bf16* ws_bf(Frame& F, size_t off) { return (bf16*)(F.ws + off); }
__device__ __forceinline__ float* ssq_f(Frame& F, int s) { return (float*)(F.ws + WS_SSQ + (size_t)s * MiB); }
__device__ __forceinline__ float* scr_f(Frame& F, int slot) { return (float*)(F.ws + WS_SCR + (size_t)slot * SCR_SLOT); }

struct CvtDesc { const float* W; bf16* dst; const float* gain; int K, N, mode, k0, n0; bool valid; };
constexpr int CVT_PITCH = 1040;
__device__ __forceinline__ void cvt_decode(Frame& F, const Args& args, int layer, int it, CvtDesc& d) {
    const int jh = layer >> 1; const bool od = (layer & 1) != 0;
    const int npad_in = od ? E_ODD_PAD : E_EVEN_PAD;
    const int n_in = (DM / 512) * (npad_in / 64), n_out = (DM / 512) * (DM / 64), n_up = (DM / 512) * (2 * DFF / 64), n_dn = (DFF / 512) * (DM / 64);
    d.valid = it < n_in + n_out + n_up + n_dn; d.mode = 0; d.gain = nullptr; int nblk;
    if (it < n_in) { d.K = DM; d.N = od ? E_ODD : E_EVEN; nblk = npad_in / 64; d.gain = F_IN(1) + (size_t)layer * DM;
        d.W = od ? F_IN(19) + (size_t)jh * DM * E_ODD : F_IN(4) + (size_t)jh * DM * E_EVEN; d.dst = od ? ws_bf(F, WS_WINO) + (size_t)jh * E_ODD_PAD * DM : ws_bf(F, WS_WINE) + (size_t)jh * E_EVEN_PAD * DM; }
    else if (it < n_in + n_out) { it -= n_in; d.K = DM; d.N = DM; nblk = DM / 64;
        d.W = (od ? F_IN(20) : F_IN(5)) + (size_t)jh * DM * DM; d.dst = ws_bf(F, od ? WS_WOUTO : WS_WOUTE) + (size_t)jh * DM * DM; }
    else if (it < n_in + n_out + n_up) { it -= n_in + n_out; d.K = DM; d.N = 2 * DFF; nblk = 2 * DFF / 64; d.mode = 1; d.gain = F_IN(2) + (size_t)layer * DM;
        d.W = F_IN(30) + (size_t)layer * DM * 2 * DFF; d.dst = ws_bf(F, WS_WUP) + (size_t)layer * 2 * DFF * DM; }
    else { it -= n_in + n_out + n_up; d.K = DFF; d.N = DM; nblk = DM / 64;
        d.W = F_IN(31) + (size_t)layer * DFF * DM; d.dst = ws_bf(F, WS_WDN) + (size_t)layer * DM * DFF; }
    d.n0 = 64 * (it % nblk); d.k0 = 512 * (it / nblk);
}
__device__ __forceinline__ void cvt_load(const CvtDesc& d, int wave, int lane, f32x4 (&v)[16]) {
    const int nn = d.n0 + 4 * (lane & 15); const bool ok = nn < d.N;
#pragma unroll
    for (int i = 0; i < 16; ++i) { const int kk = d.k0 + 64 * wave + 4 * i + (lane >> 4); v[i] = ok ? __builtin_nontemporal_load((const GAS f32x4*)(d.W + (size_t)kk * d.N + nn)) : (f32x4){0.f, 0.f, 0.f, 0.f}; }
}
__device__ __forceinline__ void cvt_put(const CvtDesc& d, int wave, int lane, const f32x4 (&v)[16], LAS unsigned char* tile) {
    const int nq = 4 * (lane & 15);
#pragma unroll
    for (int i = 0; i < 16; ++i) { const int kk = 4 * i + (lane >> 4); const float gk = d.gain ? d.gain[d.k0 + 64 * wave + kk] : 1.0f;
#pragma unroll
        for (int e = 0; e < 4; ++e) *(LAS bf16*)(tile + (nq + e) * CVT_PITCH + wave * 128 + (((kk >> 3) ^ ((nq >> 2) & 7)) * 16) + (kk & 7) * 2) = (bf16)f2bf(v[i][e] * gk); }
}
__device__ __forceinline__ void cvt_write(const CvtDesc& d, int wave, int lane, const LAS unsigned char* tile) {
    int r0 = d.n0;
    if (d.mode == 1) { r0 = (d.n0 < DFF) ? ((d.n0 >> 7) * 256 + (d.n0 & 127)) : (((d.n0 - DFF) >> 7) * 256 + 128 + ((d.n0 - DFF) & 127)); }
#pragma unroll
    for (int i = 0; i < 8; ++i) { const int n = 8 * wave + i;
        __builtin_nontemporal_store(*(const LAS v4u*)(tile + n * CVT_PITCH + (lane >> 3) * 128 + (((lane & 7) ^ ((n >> 2) & 7)) * 16)), (GAS v4u*)(d.dst + (size_t)(r0 + n) * d.K + d.k0 + lane * 8)); }
}
__device__ __forceinline__ void phase_convert(Frame& F, const Args& args, int layer, int wg0, int nwg, int p_lo = 0, int p_hi = 8) {
    if (F.bid < wg0 || F.bid >= wg0 + nwg) return;
    LAS unsigned char* tile = F.lds + RING_OFF;
    const int np = p_hi - p_lo, wave = F.wave; int lane = F.lane; OPAQUE_V(lane);
    CvtDesc dc, dn; f32x4 va[16], vb[16];
    int j = F.bid - wg0; cvt_decode(F, args, layer, 8 * (j / np) + p_lo + (j % np), dc);
    if (!dc.valid) return;
    cvt_load(dc, wave, lane, va);
    for (;;) {
        j += nwg; cvt_decode(F, args, layer, 8 * (j / np) + p_lo + (j % np), dn);
        if (dn.valid) cvt_load(dn, wave, lane, vb);
        cvt_put(dc, wave, lane, va, tile);
        __syncthreads();
        cvt_write(dc, wave, lane, tile);
        __syncthreads();
        if (!dn.valid) break;
        dc = dn;
#pragma unroll
        for (int i = 0; i < 16; ++i) va[i] = vb[i];
    }
}
__device__ __forceinline__ void probe_read_weights(Frame& F, const Args& args, int layer) {
    const int gw = F.bid, NGW = F.G; int lane = F.lane; OPAQUE_V(lane);
    CvtDesc d; f32x4 v[16]; float s = 0.f;
    for (int j = gw; ; j += NGW) { cvt_decode(F, args, layer, j, d); if (!d.valid) break; cvt_load(d, F.wave, lane, v);
#pragma unroll
        for (int i = 0; i < 16; ++i) s += (v[i][0] + v[i][1]) + (v[i][2] + v[i][3]); }
    if (s == 123.456f) scr_f(F, 21)[2000000 + gw] = s;
}
__device__ __forceinline__ void phase_convert_lora(Frame& F, const Args& args) {
    const int gw = F.bid * NWAVES + F.wave, NGW = F.G * NWAVES; int lane = F.lane; OPAQUE_V(lane);
    if (F.bid == 0) { float* lbt = (float*)(F.ws + WS_LB); const float* tab = F_IN(6);
        for (int c = F.tid; c < 1024; c += NTHREADS) { const float t0 = tab[c], t1 = tab[1024 + c], t2 = tab[2048 + c], t3 = tab[3072 + c]; const float mx = fmaxf(fmaxf(t0, t1), fmaxf(t2, t3));
            const float e0 = __expf(t0 - mx), e1 = __expf(t1 - mx), e2 = __expf(t2 - mx), e3 = __expf(t3 - mx), inv = __builtin_amdgcn_rcpf(e0 + e1 + e2 + e3);
            lbt[c] = 0.f; lbt[1024 + c] = e1 * inv; lbt[2048 + c] = (e1 + e2) * inv; lbt[3072 + c] = (e1 + e2 + e3) * inv; } }
    { bf16* lo = ws_bf(F, WS_LORA);
      for (int e = gw * 64 + lane; e < 2 * (int)LORA_LAYER; e += NGW * 64) { const int jl = e >= (int)LORA_LAYER, r = e - jl * (int)LORA_LAYER; float v;
          if (r < (int)LORA_A2) { const int c = r >> 6, jj = r & 63; v = F_IN(10)[(size_t)jl * 64 * 1024 + jj * 1024 + c]; }
          else if (r < (int)LORA_G2) { const int q = r - (int)LORA_A2, c = q >> 6, jj = q & 63; v = F_IN(12)[(size_t)jl * 64 * 1024 + jj * 1024 + c]; }
          else { const int q = r - (int)LORA_G2, c = q / 160, jj = q % 160; v = F_IN(13)[(size_t)jl * 160 * 1024 + jj * 1024 + c]; }
          lo[e] = (bf16)f2bf(v); } }
}

__device__ __forceinline__ void phase_x_init(Frame& F, const float* x, bf16* hb, float* ssq) {
    const int gw = F.bid * NWAVES + F.wave, NGW = F.G * NWAVES; int lane = F.lane; OPAQUE_V(lane);
    for (int m = gw; m < SEQ; m += NGW) {
        const GAS f32x4* xr = (const GAS f32x4*)(x + (size_t)m * DM) + lane;
        f32x4 v[8]; float s = 0.f;
#pragma unroll
        for (int j = 0; j < 8; ++j) { v[j] = __builtin_nontemporal_load(xr + 64 * j); s += (v[j].x * v[j].x + v[j].y * v[j].y) + (v[j].z * v[j].z + v[j].w * v[j].w); }
        s = wave_sum(s); if (lane < 32) ssq[(size_t)m * 32 + lane] = lane == 0 ? s : 0.f;
        GAS v2u* o8 = (GAS v2u*)(hb + (size_t)m * DM) + lane;
#pragma unroll
        for (int j = 0; j < 8; ++j) { v2u o; o.x = pk2(v[j].x, v[j].y); o.y = pk2(v[j].z, v[j].w); o8[64 * j] = o; }
    }
}
__device__ __forceinline__ void phase_final_norm(Frame& F, const float* gain, const float* ssq, const bf16* hb) {
    const int gw = F.bid * NWAVES + F.wave, NGW = F.G * NWAVES; int lane = F.lane; OPAQUE_V(lane);
    for (int m = gw; m < SEQ; m += NGW) {
        const float rstd = 1.0f / sqrtf(wave_sum(lane < 32 ? ssq[(size_t)m * 32 + lane] : 0.f) * (1.f / DM) + EPS);
#pragma unroll
        for (int j = 0; j < 4; ++j) { const int c0 = (lane + 64 * j) * 8; const v4u o = *(const v4u*)(hb + (size_t)m * DM + c0);
            const f32x4 g0 = *(const f32x4*)(gain + c0), g1 = *(const f32x4*)(gain + c0 + 4);
            const f32x4 a = (f32x4){__builtin_bit_cast(float, o.x << 16) * rstd * g0[0], __builtin_bit_cast(float, o.x & 0xffff0000u) * rstd * g0[1], __builtin_bit_cast(float, o.y << 16) * rstd * g0[2], __builtin_bit_cast(float, o.y & 0xffff0000u) * rstd * g0[3]};
            const f32x4 b = (f32x4){__builtin_bit_cast(float, o.z << 16) * rstd * g1[0], __builtin_bit_cast(float, o.z & 0xffff0000u) * rstd * g1[1], __builtin_bit_cast(float, o.w << 16) * rstd * g1[2], __builtin_bit_cast(float, o.w & 0xffff0000u) * rstd * g1[3]};
            __builtin_nontemporal_store(a, (f32x4*)(F.h + (size_t)m * DM + c0)); __builtin_nontemporal_store(b, (f32x4*)(F.h + (size_t)m * DM + c0 + 4)); }
    }
}

constexpr int S_HQ = 0, S_HF = 1, S_HK = 2, S_HO = 3, S_RR = 4, S_RW = 5, S_RK2 = 6, S_RKK = 7, S_RKKA = 8, S_RV = 9, S_RGATE = 10, S_RBONUS = 11, S_RO = 12;
constexpr int S_MQ = 0, S_MK = 1, S_MNUM = 2, S_SMALL = 3, S_BX = 4, S_BB = 5, S_BC = 6, S_BY = 7;
constexpr size_t SM_EM_POST = 3 * MiB / 4;
constexpr size_t SM_EI = 0, SM_F = 1 * MiB / 4, SM_DEN = 2 * MiB / 4, SM_DT = 4 * MiB / 4, SM_DA = 8 * MiB / 4;

__device__ __forceinline__ void phase_even_pre(Frame& F, const Args& args, int layer) {
    const int j = layer >> 1; int tid = F.tid; OPAQUE_V(tid);
    const bf16* P = ws_bf(F, WS_P);
    LAS float* lbv = (LAS float*)(F.lds);
    LAS float* lin = (LAS float*)(F.lds + 4096);
    const float* tab = F_IN(6);
    for (int c = tid; c < 1024; c += NTHREADS) {
        const float t0 = tab[c], t1 = tab[1024 + c], t2 = tab[2048 + c], t3 = tab[3072 + c];
        const float mx = fmaxf(fmaxf(t0, t1), fmaxf(t2, t3));
        const float e0 = expf(t0 - mx), e1 = expf(t1 - mx), e2 = expf(t2 - mx), e3 = expf(t3 - mx), inv = 1.0f / (e0 + e1 + e2 + e3);
        float lb = 0.f; if (layer >= 1) lb += e1 * inv; if (layer >= 2) lb += e2 * inv; if (layer >= 3) lb += e3 * inv;
        lbv[c] = lb;
    }
    __syncthreads();
    const float* mu = F_IN(8) + (size_t)j * 3360; const float* w0 = F_IN(9) + j * 1024; const float* w2 = F_IN(10) + (size_t)j * 64 * 1024;
    const float* a0 = F_IN(11) + j * 1024; const float* a2 = F_IN(12) + (size_t)j * 64 * 1024; const float* g2 = F_IN(13) + (size_t)j * 160 * 1024;
    const float* k_k = F_IN(14) + j * 1024; const float* k_a = F_IN(15) + j * 1024; const float* r_k = F_IN(16) + j * 1024;
    float* Hq = scr_f(F, S_HQ); float* Hf = scr_f(F, S_HF); float* Hk = scr_f(F, S_HK);
    float* Rr = scr_f(F, S_RR); float* Rw = scr_f(F, S_RW); float* Rk2 = scr_f(F, S_RK2); float* Rkk = scr_f(F, S_RKK); float* Rkka = scr_f(F, S_RKKA);
    float* Rv = scr_f(F, S_RV); float* Rgate = scr_f(F, S_RGATE); float* Rbonus = scr_f(F, S_RBONUS);
    for (int t = F.bid; t < SEQ; t += F.G) {
        const bf16* pr = P + (size_t)t * LDP; const bf16* pp = pr - LDP; const bool hasp = t > 0;
#pragma unroll
        for (int cc = 0; cc < 2; ++cc) { const int c = tid + 512 * cc;
            const float q = bf2f(pr[HGC_Q + c]), f = bf2f(pr[HGC_F + c]), lb = lbv[c];
            Hq[(size_t)t * 1024 + c] = silu_acc(q); Hf[(size_t)t * 1024 + c] = lb + (1.f - lb) * sigmoid_f(f); Hk[(size_t)t * 1024 + c] = (1.f - lb) * sigmoid_f(-f); }
        if (tid < 288) { const int col = RWC_WL + tid; const float p = bf2f(pr[col]), pv = hasp ? bf2f(pp[col]) : 0.f; const float xs = p + (pv - p) * mu[3072 + tid];
            lin[tid] = tid < 64 ? tanhf(xs) : (tid < 128 ? xs : sigmoid_f(xs)); }
        __syncthreads();
#pragma unroll
        for (int cc = 0; cc < 2; ++cc) { const int c = tid + 512 * cc;
            float r = bf2f(pr[RWC_R + c]), k = bf2f(pr[RWC_K + c]), v = bf2f(pr[RWC_V + c]);
            const float rp = hasp ? bf2f(pp[RWC_R + c]) : 0.f, kp = hasp ? bf2f(pp[RWC_K + c]) : 0.f, vp = hasp ? bf2f(pp[RWC_V + c]) : 0.f;
            r = r + (rp - r) * mu[c]; k = k + (kp - k) * mu[1024 + c]; v = v + (vp - v) * mu[2048 + c];
            float wd = 0.f, ad = 0.f, gt = 0.f;
            for (int jj = 0; jj < 64; ++jj) { wd += lin[jj] * w2[jj * 1024 + c]; ad += lin[64 + jj] * a2[jj * 1024 + c]; }
            for (int jj = 0; jj < 160; ++jj) gt += lin[128 + jj] * g2[jj * 1024 + c];
            const float w_log = -softplus_f(-(w0[c] + wd)) - 0.5f; const float decay = -expf(w_log);
            const float a = sigmoid_f(a0[c] + ad);
            const float kkv = k * k_k[c]; const float ss = wave_sum(kkv * kkv); const float kk = kkv / fmaxf(sqrtf(ss), 1e-12f);
            const float k2 = k * (1.f + (a - 1.f) * k_a[c]);
            const float bs = wave_sum(r * k2 * r_k[c]);
            const size_t o = (size_t)t * 1024 + c;
            Rr[o] = r; Rw[o] = decay; Rk2[o] = k2; Rkk[o] = kk; Rkka[o] = kk * a; Rv[o] = v; Rgate[o] = gt; Rbonus[o] = bs * v; }
        __syncthreads();
    }
}
__device__ __forceinline__ void phase_even_scan(Frame& F, int u_lo) {
    if (F.wave != 0) return;
    int lane_ = F.lane; OPAQUE_V(lane_);
    const bf16* P = ws_bf(F, WS_P);
    for (int u = u_lo + F.bid; u < 32; u += F.G) {
        if (u < 16) {
            const int head = u >> 1, vb = u & 1, vcol = head * 128 + vb * 64 + lane_;
            const float* Hq = scr_f(F, S_HQ) + head * 128; const float* Hf = scr_f(F, S_HF) + head * 128; const float* Hk = scr_f(F, S_HK) + head * 128; float* Ho = scr_f(F, S_HO);
            float S[128];
#pragma unroll
            for (int d = 0; d < 128; ++d) S[d] = 0.f;
            for (int t = 0; t < SEQ; ++t) {
                const float v = bf2f(P[(size_t)t * LDP + HGC_I + vcol]);
                const float* q = Hq + (size_t)t * 1024; const float* f = Hf + (size_t)t * 1024; const float* k = Hk + (size_t)t * 1024;
                float o = 0.f;
#pragma unroll
                for (int d = 0; d < 128; ++d) { S[d] = f[d] * S[d] + k[d] * v; o += q[d] * S[d]; if ((d & 15) == 15) asm volatile("" ::: "memory"); }
                Ho[(size_t)t * 1024 + vcol] = o;
            }
        } else {
            const int head = u - 16, c = head * 64 + lane_;
            const float* Rr = scr_f(F, S_RR) + head * 64; const float* Rw = scr_f(F, S_RW) + head * 64; const float* Rk2 = scr_f(F, S_RK2) + head * 64;
            const float* Rkk = scr_f(F, S_RKK) + head * 64; const float* Rkka = scr_f(F, S_RKKA) + head * 64; const float* Rv = scr_f(F, S_RV); float* Ro = scr_f(F, S_RO);
            float S[64];
#pragma unroll
            for (int d = 0; d < 64; ++d) S[d] = 0.f;
            for (int t = 0; t < SEQ; ++t) {
                const size_t tb = (size_t)t * 1024;
                const float v = Rv[tb + c];
                float sa = 0.f;
#pragma unroll
                for (int d = 0; d < 64; ++d) sa += S[d] * Rkk[tb + d];
                sa = -sa;
                float o = 0.f;
#pragma unroll
                for (int d = 0; d < 64; ++d) { S[d] = S[d] * expf(Rw[tb + d]) + sa * Rkka[tb + d] + v * Rk2[tb + d]; o += S[d] * Rr[tb + d]; }
                Ro[tb + c] = o;
            }
        }
    }
}
__device__ __forceinline__ void phase_even_post(Frame& F, const Args& args, int layer) {
    const int j = layer >> 1, w = F.wave; int lane = F.lane; OPAQUE_V(lane);
    const bf16* P = ws_bf(F, WS_P); bf16* MIX = ws_bf(F, WS_MIX);
    const float* hgn = F_IN(7) + j * 1024; const float* lnw = F_IN(17) + j * 1024; const float* lnb = F_IN(18) + j * 1024;
    const float* Ho = scr_f(F, S_HO); const float* Ro = scr_f(F, S_RO); const float* Rgate = scr_f(F, S_RGATE); const float* Rbonus = scr_f(F, S_RBONUS);
    for (int t = F.bid; t < SEQ; t += F.G) {
        const size_t tb = (size_t)t * 1024;
        { const int c0 = w * 128 + lane, c1 = c0 + 64; const float o0 = Ho[tb + c0], o1 = Ho[tb + c1];
          const float ss = wave_sum(o0 * o0 + o1 * o1); const float r = __builtin_amdgcn_rsqf(ss * (1.f / 128.f) + EPS);
          const float g0 = bf2f(P[(size_t)t * LDP + HGC_G + c0]), g1 = bf2f(P[(size_t)t * LDP + HGC_G + c1]);
          MIX[(size_t)t * DM + c0] = (bf16)f2bf(o0 * r * hgn[c0] * sigmoid_f(g0)); MIX[(size_t)t * DM + c1] = (bf16)f2bf(o1 * r * hgn[c1] * sigmoid_f(g1)); }
#pragma unroll
        for (int hh = 0; hh < 2; ++hh) { const int c = (w + 8 * hh) * 64 + lane; const float o = Ro[tb + c];
            const float mu = wave_sum(o) * (1.f / 64.f); const float d = o - mu; const float var = wave_sum(d * d) * (1.f / 64.f);
            float y = d * __builtin_amdgcn_rsqf(var + 64e-5f) * lnw[c] + lnb[c]; y = (y + Rbonus[tb + c]) * Rgate[tb + c];
            MIX[(size_t)t * DM + 1024 + c] = (bf16)f2bf(y); }
    }
}

__device__ __forceinline__ void phase_odd_pre(Frame& F, const Args& args, int layer) {
    const int j = layer >> 1; int tid = F.tid; OPAQUE_V(tid);
    const bf16* P = ws_bf(F, WS_P);
    const float* ib = F_IN(21) + j * 4; const float* fb = F_IN(22) + j * 4; const float* cw = F_IN(24) + (size_t)j * 4 * 1536; const float* cb = F_IN(25) + j * 1536;
    const float* dtb = F_IN(26) + j * 16; const float* Alog = F_IN(27) + j * 16;
    float* Mq = scr_f(F, S_MQ); float* Mk = scr_f(F, S_MK); float* sm = scr_f(F, S_SMALL);
    float* Bx = scr_f(F, S_BX); float* BB = scr_f(F, S_BB); float* BC = scr_f(F, S_BC);
    for (int t = F.bid; t < SEQ; t += F.G) {
        const bf16* pr = P + (size_t)t * LDP;
        Mq[(size_t)t * 512 + tid] = bf2f(pr[MLC_Q + tid]) * 0.08838834764831845f; Mk[(size_t)t * 512 + tid] = bf2f(pr[MLC_K + tid]);
        if (tid < 4) { const float ig = bf2f(pr[MLC_I + tid]) + ib[tid], fg = bf2f(pr[MLC_F + tid]) + fb[tid];
            const float ip = 15.f * tanhf(ig * (1.f / 15.f)), fp = 15.f * tanhf(fg * (1.f / 15.f));
            sm[SM_EI + (size_t)t * 4 + tid] = ip; sm[SM_F + (size_t)t * 4 + tid] = -softplus_acc(-fp); }
        if (tid >= 64 && tid < 80) { const int hh = tid - 64; const float dt = softplus_acc(bf2f(pr[MBC_DT + hh]) + dtb[hh]);
            sm[SM_DT + (size_t)t * 16 + hh] = dt; sm[SM_DA + (size_t)t * 16 + hh] = -expf(Alog[hh]) * dt; }
#pragma unroll
        for (int cc = 0; cc < 3; ++cc) { const int c = tid + 512 * cc; float acc = cb[c];
#pragma unroll
            for (int jj = 0; jj < 4; ++jj) { const int tt = t - 3 + jj; if (tt >= 0) acc += cw[jj * 1536 + c] * bf2f(P[(size_t)tt * LDP + MBC_X + c]); }
            const float s = silu_acc(acc);
            if (c < 1024) Bx[(size_t)t * 1024 + c] = s; else if (c < 1280) BB[(size_t)t * 256 + (c - 1024)] = s; else BC[(size_t)t * 256 + (c - 1280)] = s; }
    }
}
__device__ __forceinline__ void phase_odd_scan(Frame& F, int u_lo, int u_hi) {
    if (F.wave != 0) return;
    int lane_ = F.lane; OPAQUE_V(lane_);
    const bf16* P = ws_bf(F, WS_P);
    float* sm = scr_f(F, S_SMALL);
    for (int u = u_lo + F.bid; u < u_hi; u += F.G) {
        if (u < 20) {
            const int head = u / 5, blk = u % 5, col = blk * 64 + lane_;
            const float* Mq = scr_f(F, S_MQ) + head * 128; const float* Mk = scr_f(F, S_MK) + head * 128; float* Mnum = scr_f(F, S_MNUM);
            float S[128];
#pragma unroll
            for (int d = 0; d < 128; ++d) S[d] = 0.f;
            for (int t = 0; t < SEQ; ++t) {
                const float ei = expf(sm[SM_EI + (size_t)t * 4 + head]), f = expf(sm[SM_F + (size_t)t * 4 + head]);
                float vv = 0.f; if (col < 256) vv = bf2f(P[(size_t)t * LDP + MLC_V + head * 256 + col]); else if (col == 256) vv = 1.f;
                const float ev = ei * vv;
                const float* q = Mq + (size_t)t * 512; const float* k = Mk + (size_t)t * 512;
                float num = 0.f;
#pragma unroll
                for (int d = 0; d < 128; ++d) { S[d] = f * S[d] + ev * k[d]; num += q[d] * S[d]; if ((d & 15) == 15) asm volatile("" ::: "memory"); }
                if (col < 256) Mnum[(size_t)t * 1024 + head * 256 + col] = num; else if (col == 256) sm[SM_DEN + (size_t)t * 4 + head] = num;
            }
        } else {
            const int head = u - 20, g = head >> 3, c = head * 64 + lane_;
            const float* Bx = scr_f(F, S_BX); const float* BB = scr_f(F, S_BB) + g * 128; const float* BC = scr_f(F, S_BC) + g * 128; float* By = scr_f(F, S_BY);
            float S[128];
#pragma unroll
            for (int d = 0; d < 128; ++d) S[d] = 0.f;
            for (int t = 0; t < SEQ; ++t) {
                const float x = Bx[(size_t)t * 1024 + c], dt = sm[SM_DT + (size_t)t * 16 + head], dA = expf(sm[SM_DA + (size_t)t * 16 + head]);
                const float dx = dt * x; const float* B = BB + (size_t)t * 256; const float* C = BC + (size_t)t * 256;
                float y = 0.f;
#pragma unroll
                for (int d = 0; d < 128; ++d) { S[d] = dA * S[d] + dx * B[d]; y += C[d] * S[d]; if ((d & 15) == 15) asm volatile("" ::: "memory"); }
                By[(size_t)t * 1024 + c] = y;
            }
        }
    }
}
__device__ __forceinline__ void phase_odd_post(Frame& F, const Args& args, int layer) {
    const int j = layer >> 1, w = F.wave; int tid = F.tid; OPAQUE_V(tid); const int lane = tid & 63;
    const bf16* P = ws_bf(F, WS_P); bf16* MIX = ws_bf(F, WS_MIX);
    const float* mln = F_IN(23) + j * 1024; const float* Dp = F_IN(28) + j * 16; const float* mbn = F_IN(29) + j * 1024;
    const float* Mnum = scr_f(F, S_MNUM); const float* sm = scr_f(F, S_SMALL); const float* Bx = scr_f(F, S_BX); const float* By = scr_f(F, S_BY);
    LAS float* red = (LAS float*)(F.lds);
    for (int t = F.bid; t < SEQ; t += F.G) {
        const bf16* pr = P + (size_t)t * LDP; const size_t tb = (size_t)t * 1024;
        if (w < 4) { const float den = sm[SM_DEN + (size_t)t * 4 + w]; const float dn = 1.0f / fmaxf(fabsf(den), sm[SM_EM_POST + (size_t)t * 4 + w]);
            float hv[4]; float ss = 0.f;
#pragma unroll
            for (int i = 0; i < 4; ++i) { hv[i] = Mnum[tb + w * 256 + lane + 64 * i] * dn; ss += hv[i] * hv[i]; }
            ss = wave_sum(ss); const float r = __builtin_amdgcn_rsqf(ss * (1.f / 256.f) + EPS);
#pragma unroll
            for (int i = 0; i < 4; ++i) { const int c = w * 256 + lane + 64 * i; const float og = bf2f(pr[MLC_O + c]);
                MIX[(size_t)t * DM + c] = (bf16)f2bf(hv[i] * r * mln[c] * sigmoid_f(og)); } }
        float yv[2];
#pragma unroll
        for (int cc = 0; cc < 2; ++cc) { const int c = tid + 512 * cc; const float z = bf2f(pr[MBC_Z + c]);
            yv[cc] = (By[tb + c] + Bx[tb + c] * Dp[c >> 6]) * silu_acc(z);
            const float s = wave_sum(yv[cc] * yv[cc]); if (lane == 0) red[w * 2 + cc] = s; }
        __syncthreads();
#pragma unroll
        for (int cc = 0; cc < 2; ++cc) { float tot = 0.f;
#pragma unroll
            for (int ww = 0; ww < 8; ++ww) tot += red[ww * 2 + cc];
            const int c = tid + 512 * cc; const float r = __builtin_amdgcn_rsqf(tot * (1.f / 512.f) + EPS);
            MIX[(size_t)t * DM + 1024 + c] = (bf16)f2bf(yv[cc] * r * mbn[c]); }
        __syncthreads();
    }
}

typedef short bf16x8v __attribute__((ext_vector_type(8)));
typedef float f32x16 __attribute__((ext_vector_type(16)));
constexpr int NCHUNK = SEQ / 64;
constexpr int S_U = 13;
constexpr int S_HS = 15;
constexpr int S_HD = 16;
constexpr int S_RMQ = 17, S_RN = 18, S_ROL = 19, S_RS = 20;
constexpr int S_MS = 16;
constexpr int S_BU = 18;
constexpr int S_BS = 20;
constexpr int S_OSM = 21;

__device__ __forceinline__ void mma32(f32x16& acc, const LAS unsigned char* A, int pa, const LAS unsigned char* Bt, int pb, int ksteps, int lane) {
    const LAS unsigned char* ap = A + (lane & 31) * pa + (lane >> 5) * 16;
    const LAS unsigned char* bp = Bt + (lane & 31) * pb + (lane >> 5) * 16;
    for (int ks = 0; ks < ksteps; ++ks) {
        const bf16x8v a = *(const LAS bf16x8v*)(ap + ks * 32), b = *(const LAS bf16x8v*)(bp + ks * 32);
        acc = __builtin_amdgcn_mfma_f32_32x32x16_bf16(a, b, acc, 0, 0, 0);
    }
}
template <int KS> __device__ __forceinline__ void mma32_gb(f32x16& acc, const LAS unsigned char* A, int pa, const unsigned char* Bt, int pb, int lane) {
    const LAS unsigned char* ap = A + (lane & 31) * pa + (lane >> 5) * 16;
    const unsigned char* bp = Bt + (size_t)(lane & 31) * pb + (lane >> 5) * 16;
    bf16x8v b[KS];
#pragma unroll
    for (int ks = 0; ks < KS; ++ks) b[ks] = *(const bf16x8v*)(bp + ks * 32);
#pragma unroll
    for (int ks = 0; ks < KS; ++ks) { const bf16x8v a = *(const LAS bf16x8v*)(ap + ks * 32); acc = __builtin_amdgcn_mfma_f32_32x32x16_bf16(a, b[ks], acc, 0, 0, 0); }
}
template <int KS> __device__ __forceinline__ void bfrag_load(bf16x8v (&b)[KS], const unsigned char* Bt, int pb, int lane) {
    const unsigned char* bp = Bt + (size_t)(lane & 31) * pb + (lane >> 5) * 16;
#pragma unroll
    for (int ks = 0; ks < KS; ++ks) b[ks] = *(const bf16x8v*)(bp + ks * 32);
}
template <int KS> __device__ __forceinline__ void mma32_pre(f32x16& acc, const LAS unsigned char* A, int pa, const bf16x8v (&b)[KS], int lane) {
    const LAS unsigned char* ap = A + (lane & 31) * pa + (lane >> 5) * 16;
#pragma unroll
    for (int ks = 0; ks < KS; ++ks) { const bf16x8v a = *(const LAS bf16x8v*)(ap + ks * 32); acc = __builtin_amdgcn_mfma_f32_32x32x16_bf16(a, b[ks], acc, 0, 0, 0); }
}
__device__ __forceinline__ void mma32_gbl(f32x16& acc, const LAS unsigned char* A, int pa, const unsigned char* Bt, int pb, int ksteps, int lane) {
    const LAS unsigned char* ap = A + (lane & 31) * pa + (lane >> 5) * 16;
    const unsigned char* bp = Bt + (size_t)(lane & 31) * pb + (lane >> 5) * 16;
    for (int ks = 0; ks < ksteps; ++ks) {
        const bf16x8v a = *(const LAS bf16x8v*)(ap + ks * 32); const bf16x8v b = *(const bf16x8v*)(bp + ks * 32);
        acc = __builtin_amdgcn_mfma_f32_32x32x16_bf16(a, b, acc, 0, 0, 0);
    }
}
#define ACC_ROW(i, lane) (((i) & 3) + 8 * ((i) >> 2) + 4 * ((lane) >> 5))
__device__ __forceinline__ f32x16 zero16() { f32x16 z;
#pragma unroll
    for (int i = 0; i < 16; ++i) z[i] = 0.f;
    return z; }
__device__ __forceinline__ void store_tile_bf16(LAS unsigned char* blk, const f32x16& acc, bf16* out, size_t ldo, int lane) {
#pragma unroll
    for (int i = 0; i < 16; ++i) *(LAS bf16*)(blk + ACC_ROW(i, lane) * 64 + (lane & 31) * 2) = (bf16)f2bf(acc[i]);
    LDS_WAIT(); asm volatile("" ::: "memory");
#pragma unroll
    for (int q = 0; q < 2; ++q) { const int p = lane + 64 * q, row = p >> 2, pc = p & 3; *(v4u*)(out + (size_t)row * ldo + pc * 8) = *(const LAS v4u*)(blk + row * 64 + pc * 16); }
    LDS_WAIT(); asm volatile("" ::: "memory");
}
__device__ __forceinline__ float exp_c(float x) { return __expf(fminf(x, 80.f)); }

__device__ __forceinline__ void unpack8(const v4u p, float (&o)[8]) {
    o[0] = __builtin_bit_cast(float, p.x << 16); o[1] = __builtin_bit_cast(float, p.x & 0xffff0000u); o[2] = __builtin_bit_cast(float, p.y << 16); o[3] = __builtin_bit_cast(float, p.y & 0xffff0000u);
    o[4] = __builtin_bit_cast(float, p.z << 16); o[5] = __builtin_bit_cast(float, p.z & 0xffff0000u); o[6] = __builtin_bit_cast(float, p.w << 16); o[7] = __builtin_bit_cast(float, p.w & 0xffff0000u);
}
__device__ __forceinline__ void load8f(const float* p, float (&o)[8]) { const f32x4 a = *(const f32x4*)p, b = *(const f32x4*)(p + 4); o[0] = a[0]; o[1] = a[1]; o[2] = a[2]; o[3] = a[3]; o[4] = b[0]; o[5] = b[1]; o[6] = b[2]; o[7] = b[3]; }
__device__ __forceinline__ void store8f(float* p, const float (&o)[8]) { *(f32x4*)p = (f32x4){o[0], o[1], o[2], o[3]}; *(f32x4*)(p + 4) = (f32x4){o[4], o[5], o[6], o[7]}; }
__device__ __forceinline__ v4u pack8(const float (&o)[8]) { return (v4u){pk2(o[0], o[1]), pk2(o[2], o[3]), pk2(o[4], o[5]), pk2(o[6], o[7])}; }
template <int W> __device__ __forceinline__ float group_sum(float v) {
    if constexpr (W > 1) v = dpp_add<0xB1>(v);
    if constexpr (W > 2) v = dpp_add<0x4E>(v);
    if constexpr (W > 4) v = dpp_add<0x141>(v);
    if constexpr (W > 8) v = dpp_add<0x140>(v);
    if constexpr (W > 16) v += xshfl<16>(v);
    if constexpr (W > 32) v += xshfl<32>(v);
    return v;
}
__device__ __forceinline__ void phase_even_post2(Frame& F, const Args& args, int layer) {
    const int j = layer >> 1; int lane = F.lane; OPAQUE_V(lane);
    const int gw = F.bid * NWAVES + F.wave, NGW = F.G * NWAVES;
    const bf16* P = ws_bf(F, WS_P); bf16* MIX = ws_bf(F, WS_MIX);
    const float* hgn = F_IN(7) + j * 1024; const float* lnw = F_IN(17) + j * 1024; const float* lnb = F_IN(18) + j * 1024;
    const bf16* Ho = (const bf16*)scr_f(F, S_HO); const bf16* Ro = (const bf16*)scr_f(F, S_RO); const bf16* Rgate = (const bf16*)scr_f(F, S_RGATE); const float* Rbs = scr_f(F, S_RBONUS); const bf16* Rv = (const bf16*)scr_f(F, S_RV);
    for (int t = gw; t < SEQ; t += NGW) {
        const size_t tb = (size_t)t * 1024;
        float o[2][8], g[2][8], ro[2][8], ga[2][8], bo[2][8];
#pragma unroll
        for (int it = 0; it < 2; ++it) { const int c0 = (lane + 64 * it) * 8;
            unpack8(*(const v4u*)(Ho + tb + c0), o[it]); unpack8(*(const v4u*)(P + (size_t)t * LDP + HGC_G + c0), g[it]);
            unpack8(*(const v4u*)(Ro + tb + c0), ro[it]); unpack8(*(const v4u*)(Rgate + tb + c0), ga[it]); unpack8(*(const v4u*)(Rv + tb + c0), bo[it]); { const float bsc = Rbs[(size_t)t * 16 + (c0 >> 6)];
#pragma unroll
                for (int e = 0; e < 8; ++e) bo[it][e] *= bsc; } }
#pragma unroll
        for (int it = 0; it < 2; ++it) { const int c0 = (lane + 64 * it) * 8; float nv[8], out[8]; load8f(hgn + c0, nv);
            float ss = 0.f;
#pragma unroll
            for (int e = 0; e < 8; ++e) ss += o[it][e] * o[it][e];
            ss = group_sum<16>(ss); const float r = __builtin_amdgcn_rsqf(ss * (1.f / 128.f) + EPS);
#pragma unroll
            for (int e = 0; e < 8; ++e) out[e] = o[it][e] * r * nv[e] * sigmoid_f(g[it][e]);
            *(v4u*)(MIX + (size_t)t * DM + c0) = pack8(out); }
#pragma unroll
        for (int it = 0; it < 2; ++it) { const int c0 = (lane + 64 * it) * 8; float wv[8], bv[8], out[8]; load8f(lnw + c0, wv); load8f(lnb + c0, bv);
            float s1 = 0.f;
#pragma unroll
            for (int e = 0; e < 8; ++e) s1 += ro[it][e];
            const float mu = group_sum<8>(s1) * (1.f / 64.f); float s2 = 0.f;
#pragma unroll
            for (int e = 0; e < 8; ++e) { ro[it][e] -= mu; s2 += ro[it][e] * ro[it][e]; }
            const float rs = __builtin_amdgcn_rsqf(group_sum<8>(s2) * (1.f / 64.f) + 64e-5f);
#pragma unroll
            for (int e = 0; e < 8; ++e) out[e] = (ro[it][e] * rs * wv[e] + bv[e] + bo[it][e]) * ga[it][e];
            *(v4u*)(MIX + (size_t)t * DM + 1024 + c0) = pack8(out); }
    }
}
__device__ __forceinline__ void phase_odd_post2(Frame& F, const Args& args, int layer) {
    const int j = layer >> 1; int lane = F.lane; OPAQUE_V(lane);
    const int gw = F.bid * NWAVES + F.wave, NGW = F.G * NWAVES;
    const bf16* P = ws_bf(F, WS_P); bf16* MIX = ws_bf(F, WS_MIX);
    const float* mln = F_IN(23) + j * 1024; const float* Dp = F_IN(28) + j * 16; const float* mbn = F_IN(29) + j * 1024;
    const bf16* Mnum = (const bf16*)scr_f(F, S_MNUM); const float* sm = scr_f(F, S_SMALL); const bf16* Bx = (const bf16*)scr_f(F, S_BX); const bf16* By = (const bf16*)scr_f(F, S_BY);
    for (int t = gw; t < SEQ; t += NGW) {
        const size_t tb = (size_t)t * 1024; const bf16* pr = P + (size_t)t * LDP;
        float nu[2][8], og[2][8], by[2][8], bx[2][8], z[2][8], den[2], em[2];
#pragma unroll
        for (int it = 0; it < 2; ++it) { const int c0 = (lane + 64 * it) * 8;
            unpack8(*(const v4u*)(Mnum + tb + c0), nu[it]); unpack8(*(const v4u*)(pr + MLC_O + c0), og[it]); den[it] = sm[SM_DEN + (size_t)t * 4 + (c0 >> 8)]; em[it] = sm[SM_EM_POST + (size_t)t * 4 + (c0 >> 8)];
            unpack8(*(const v4u*)(By + tb + c0), by[it]); unpack8(*(const v4u*)(Bx + tb + c0), bx[it]); unpack8(*(const v4u*)(pr + MBC_Z + c0), z[it]); }
#pragma unroll
        for (int it = 0; it < 2; ++it) { const int c0 = (lane + 64 * it) * 8; float nv[8], out[8]; load8f(mln + c0, nv);
            const float dn = __builtin_amdgcn_rcpf(fmaxf(fabsf(den[it]), em[it])); float ss = 0.f;
#pragma unroll
            for (int e = 0; e < 8; ++e) { nu[it][e] *= dn; ss += nu[it][e] * nu[it][e]; }
            ss = group_sum<32>(ss); const float r = __builtin_amdgcn_rsqf(ss * (1.f / 256.f) + EPS);
#pragma unroll
            for (int e = 0; e < 8; ++e) out[e] = nu[it][e] * r * nv[e] * sigmoid_f(og[it][e]);
            *(v4u*)(MIX + (size_t)t * DM + c0) = pack8(out); }
#pragma unroll
        for (int it = 0; it < 2; ++it) { const int c0 = (lane + 64 * it) * 8; float nv[8], out[8]; load8f(mbn + c0, nv); const float dsk = Dp[c0 >> 6];
            float ss = 0.f;
#pragma unroll
            for (int e = 0; e < 8; ++e) { by[it][e] = (by[it][e] + bx[it][e] * dsk) * silu_acc(z[it][e]); ss += by[it][e] * by[it][e]; }
            ss = group_sum<64>(ss); const float r = __builtin_amdgcn_rsqf(ss * (1.f / 512.f) + EPS);
#pragma unroll
            for (int e = 0; e < 8; ++e) out[e] = by[it][e] * r * nv[e];
            *(v4u*)(MIX + (size_t)t * DM + 1024 + c0) = pack8(out); }
    }
}
__device__ __forceinline__ void phase_odd_pre2(Frame& F, const Args& args, int layer) {
    const int j = layer >> 1; int lane = F.lane; OPAQUE_V(lane);
    const int gw = F.bid * NWAVES + F.wave, NGW = F.G * NWAVES;
    const bf16* P = ws_bf(F, WS_P);
    const float* ib = F_IN(21) + j * 4; const float* fb = F_IN(22) + j * 4; const float* cw = F_IN(24) + (size_t)j * 4 * 1536; const float* cb = F_IN(25) + j * 1536;
    const float* dtb = F_IN(26) + j * 16; const float* Alog = F_IN(27) + j * 16;
    bf16* Mq = (bf16*)scr_f(F, S_MQ); bf16* Mk = (bf16*)scr_f(F, S_MK); float* sm = scr_f(F, S_SMALL);
    bf16* Bx = (bf16*)scr_f(F, S_BX); bf16* BB = (bf16*)scr_f(F, S_BB); bf16* BC = (bf16*)scr_f(F, S_BC);
    for (int t = gw; t < SEQ; t += NGW) {
        const bf16* pr = P + (size_t)t * LDP;
        { const int c0 = lane * 8; float q[8], k[8]; unpack8(*(const v4u*)(pr + MLC_Q + c0), q); unpack8(*(const v4u*)(pr + MLC_K + c0), k);
          float qs = 0.08838834764831845f; OPAQUE_V(qs);
#pragma unroll
          for (int e = 0; e < 8; ++e) q[e] *= qs;
          *(v4u*)(Mq + (size_t)t * 512 + c0) = pack8(q); *(v4u*)(Mk + (size_t)t * 512 + c0) = pack8(k); }
        if (lane < 4) { const float ig = bf2f(pr[MLC_I + lane]) + ib[lane], fg = bf2f(pr[MLC_F + lane]) + fb[lane];
            const float ip = 15.f * tanh_f(ig * (1.f / 15.f)), fp = 15.f * tanh_f(fg * (1.f / 15.f));
            sm[SM_EI + (size_t)t * 4 + lane] = ip; sm[SM_F + (size_t)t * 4 + lane] = -softplus_acc(-fp); }
        if (lane >= 8 && lane < 24) { const int hh = lane - 8; const float dt = softplus_acc(bf2f(pr[MBC_DT + hh]) + dtb[hh]);
            sm[SM_DT + (size_t)t * 16 + hh] = dt; sm[SM_DA + (size_t)t * 16 + hh] = -__expf(Alog[hh]) * dt; }
#pragma unroll
        for (int it = 0; it < 3; ++it) { const int c0 = (lane + 64 * it) * 8; float acc[8]; load8f(cb + c0, acc);
#pragma unroll
            for (int jj = 0; jj < 4; ++jj) { const int tt = t - 3 + jj; if (tt >= 0) { float xv[8], wv[8]; unpack8(*(const v4u*)(P + (size_t)tt * LDP + MBC_X + c0), xv); load8f(cw + jj * 1536 + c0, wv);
#pragma unroll
                    for (int e = 0; e < 8; ++e) acc[e] += wv[e] * xv[e]; } }
#pragma unroll
            for (int e = 0; e < 8; ++e) acc[e] = silu_acc(acc[e]);
            if (c0 < 1024) *(v4u*)(Bx + (size_t)t * 1024 + c0) = pack8(acc); else if (c0 < 1280) *(v4u*)(BB + (size_t)t * 256 + (c0 - 1024)) = pack8(acc); else *(v4u*)(BC + (size_t)t * 256 + (c0 - 1280)) = pack8(acc); }
    }
}

constexpr int PE_LBV = 0, PE_LIN = 8192, PE_LINP = 592, PE_STG = 28672, PE_STGW = 12800;
__device__ __forceinline__ float half_sum32(float v) {
    v = row16_sum(v); v += xshfl<16>(v);
    return v;
}
__device__ __forceinline__ void phase_even_pre2(Frame& F, const Args& args, int layer) {
    const int j = layer >> 1; int tid = F.tid; OPAQUE_V(tid);
    const int lane = tid & 63, w = F.wave, cl = lane & 31;
    const bf16* P = ws_bf(F, WS_P);
    LAS unsigned char* L = F.lds;
    const float* mu = F_IN(8) + (size_t)j * 3360; const float* w0 = F_IN(9) + j * 1024; const float* a0 = F_IN(11) + j * 1024;
    const float* k_k = F_IN(14) + j * 1024; const float* k_a = F_IN(15) + j * 1024; const float* r_k = F_IN(16) + j * 1024;
    const bf16* lora = ws_bf(F, WS_LORA) + (size_t)j * LORA_LAYER;
    v4u* RA = (v4u*)scr_f(F, S_RR); v2u* RB = (v2u*)scr_f(F, S_RK2);
    bf16* Rv = (bf16*)scr_f(F, S_RV); bf16* Rgate = (bf16*)scr_f(F, S_RGATE); float* Rbs = scr_f(F, S_RBONUS);
    for (int tile = F.bid; tile < SEQ / 32; tile += F.G) {
        const size_t t0 = (size_t)tile * 32;
        { const int tl = tid >> 4, jq = tid & 15; const size_t t = t0 + tl; const bool hasp = t > 0;
          const bf16* pr = P + t * LDP + RWC_WL + jq; const bf16* pp = P + (hasp ? t - 1 : t) * LDP + RWC_WL + jq; const float* mp = mu + 3072 + jq;
          bf16 cu[18], pu[18]; float mw[18];
#pragma unroll
          for (int i = 0; i < 18; ++i) { cu[i] = pr[16 * i]; pu[i] = pp[16 * i]; mw[i] = mp[16 * i]; }
#pragma unroll
          for (int i = 0; i < 18; ++i) { const int jj = jq + 16 * i; const float p = bf2f(cu[i]), pv = hasp ? bf2f(pu[i]) : 0.f; const float xs = p + (pv - p) * mw[i];
              const float val = jj < 64 ? tanh_f(xs) : (jj < 128 ? xs : sigmoid_f(xs));
              *(LAS bf16*)(L + PE_LIN + tl * PE_LINP + jj * 2) = (bf16)f2bf(val); } }
        __syncthreads();
        for (int hh = 0; hh < 2; ++hh) { const int head = w + 8 * hh;
            LAS unsigned char* stg = L + PE_STG + w * PE_STGW;
            v4u pc[15];
#pragma unroll
            for (int a = 0; a < 3; ++a)
#pragma unroll
                for (int i = 0; i < 5; ++i) { const int row = (lane >> 3) + 8 * i; const long tt = (long)t0 - 1 + row;
                    pc[a * 5 + i] = (row < 33 && tt >= 0) ? __builtin_nontemporal_load((const v4u*)(P + (size_t)tt * LDP + RWC_R + a * 1024 + head * 64 + (lane & 7) * 8)) : (v4u){0u, 0u, 0u, 0u}; }
            bf16x8v g0[10], g1[10], wf[2][4], af[2][4];
            bfrag_load<10>(g0, (const unsigned char*)(lora + LORA_G2 + (size_t)(head * 64) * 160), 320, lane);
            bfrag_load<10>(g1, (const unsigned char*)(lora + LORA_G2 + (size_t)(head * 64 + 32) * 160), 320, lane);
            { f32x16 gt = zero16(); mma32_pre<10>(gt, L + PE_LIN + 256, PE_LINP, g0, lane);
              bfrag_load<4>(wf[0], (const unsigned char*)(lora + (size_t)(head * 64) * 64), 128, lane); bfrag_load<4>(af[0], (const unsigned char*)(lora + LORA_A2 + (size_t)(head * 64) * 64), 128, lane);
#pragma unroll
              for (int i = 0; i < 16; ++i) { int trow = ACC_ROW(i, lane); OPAQUE_V(trow); Rgate[(t0 + trow) * 1024 + head * 64 + cl] = (bf16)f2bf(gt[i]); } }
            { f32x16 gt = zero16(); mma32_pre<10>(gt, L + PE_LIN + 256, PE_LINP, g1, lane);
              bfrag_load<4>(wf[1], (const unsigned char*)(lora + (size_t)(head * 64 + 32) * 64), 128, lane); bfrag_load<4>(af[1], (const unsigned char*)(lora + LORA_A2 + (size_t)(head * 64 + 32) * 64), 128, lane);
#pragma unroll
              for (int i = 0; i < 16; ++i) { int trow = ACC_ROW(i, lane); OPAQUE_V(trow); Rgate[(t0 + trow) * 1024 + head * 64 + 32 + cl] = (bf16)f2bf(gt[i]); } }
            LDS_WAIT(); asm volatile("" ::: "memory");
#pragma unroll
            for (int a = 0; a < 3; ++a)
#pragma unroll
                for (int i = 0; i < 5; ++i) { const int row = (lane >> 3) + 8 * i; if (row < 33) *(LAS v4u*)(stg + row * 384 + a * 128 + (lane & 7) * 16) = pc[a * 5 + i]; }
            LDS_WAIT(); asm volatile("" ::: "memory");
            f32x16 wd[2], ad[2];
#pragma unroll
            for (int ct = 0; ct < 2; ++ct) { const int crow = head * 64 + ct * 32; wd[ct] = zero16(); ad[ct] = zero16();
                mma32_pre<4>(wd[ct], L + PE_LIN, PE_LINP, wf[ct], lane);
                mma32_pre<4>(ad[ct], L + PE_LIN + 128, PE_LINP, af[ct], lane); (void)crow; }
            float pw0[2], pa0[2], pkk[2], pka[2], prk[2], pmr[2], pmk[2], pmv[2];
#pragma unroll
            for (int ct = 0; ct < 2; ++ct) { const int c = head * 64 + ct * 32 + cl; pw0[ct] = w0[c]; pa0[ct] = a0[c]; pkk[ct] = k_k[c]; pka[ct] = k_a[c]; prk[ct] = r_k[c]; pmr[ct] = mu[c]; pmk[ct] = mu[1024 + c]; pmv[ct] = mu[2048 + c]; }
            unsigned pv[3][2];
            const size_t obase = ((size_t)tile * 16 + head) * 1024 + lane;
#pragma unroll
            for (int i = 0; i < 16; ++i) { int trow = ACC_ROW(i, lane); OPAQUE_V(trow); const size_t t = t0 + trow;
                float rr[2], kv[2], vv[2], av[2], kkv[2], k2[2], lwv[2]; float ss = 0.f, bs = 0.f;
#pragma unroll
                for (int ct = 0; ct < 2; ++ct) { const int c = head * 64 + ct * 32 + cl;
                    const LAS bf16* sp = (const LAS bf16*)(stg + (trow + 1) * 384) + ct * 32 + cl; const LAS bf16* spp = (const LAS bf16*)(stg + trow * 384) + ct * 32 + cl;
                    float r = bf2f(sp[0]), k = bf2f(sp[64]), v = bf2f(sp[128]);
                    const float rp = bf2f(spp[0]), kp = bf2f(spp[64]), vp = bf2f(spp[128]);
                    r = r + (rp - r) * pmr[ct]; k = k + (kp - k) * pmk[ct]; v = v + (vp - v) * pmv[ct];
                    lwv[ct] = -0.60653066f * sigmoid_f(pw0[ct] + wd[ct][i]);
                    const float a = sigmoid_f(pa0[ct] + ad[ct][i]); av[ct] = a;
                    kkv[ct] = k * pkk[ct]; k2[ct] = k * (1.f + (a - 1.f) * pka[ct]); rr[ct] = r; kv[ct] = k; vv[ct] = v;
                    ss += kkv[ct] * kkv[ct]; bs += r * k2[ct] * prk[ct]; }
                ss = half_sum32(ss); bs = half_sum32(bs);
                const float inv = __builtin_amdgcn_rcpf(fmaxf(__builtin_amdgcn_sqrtf(ss), 1e-12f));
#pragma unroll
                for (int ct = 0; ct < 2; ++ct) { const size_t o = t * 1024 + head * 64 + ct * 32 + cl; const float kk = kkv[ct] * inv, kka = kk * av[ct];
                    Rv[o] = (bf16)f2bf(vv[ct]);
                    const unsigned qa = pk2(rr[ct], k2[ct]), qb = pk2(kk, kka), qc = (unsigned)__builtin_bit_cast(unsigned short, (_Float16)lwv[ct]) | (f2bf(vv[ct]) << 16);
                    if ((i & 1) == 0) { pv[0][ct] = qa; pv[1][ct] = qb; pv[2][ct] = qc; }
                    else { const size_t rec = obase + (size_t)ct * 512 + (i >> 1) * 64;
                        const unsigned ea = pv[0][ct], eb = pv[1][ct], ec = pv[2][ct];
                        RA[rec] = (v4u){(ea & 0xffffu) | (qa << 16), (ea >> 16) | (qa & 0xffff0000u), (eb & 0xffffu) | (qb << 16), (eb >> 16) | (qb & 0xffff0000u)};
                        RB[rec] = (v2u){(ec & 0xffffu) | (qc << 16), (ec >> 16) | (qc & 0xffff0000u)}; } }
                if (cl == 0) Rbs[t * 16 + head] = bs;
                asm volatile("" ::: "memory"); }
        }
        __syncthreads();
    }
}

constexpr int HA_KT = 0, HA_VT = 18432, HA_SEG = 36864;
constexpr int HC_QT = 0, HC_KT = 17408, HC_QH = 34816, HC_VT = 52224, HC_SC = 70656, HC_ST = 79872, HC_SEG = 114688;
static_assert(HC_SEG + 2048 + 4 * 2048 <= RING_BYTES && 4 * 2048 <= 9216, "HGRN2 LDS map");

#define HG_CUMSUM(SEGOFF)                                                                                         \
    float r[16]; { float run = 0.f;                                                                               \
        _Pragma("unroll") for (int i = 0; i < 16; ++i) { run += __logf((float)Hf[(row0 + i) * 1024 + h * 128 + d]); r[i] = run; } \
        segtot[seg * 128 + d] = run; }                                                                            \
    __syncthreads();                                                                                              \
    float off = 0.f, tot = 0.f; { _Pragma("unroll") for (int s = 0; s < 4; ++s) { const float sv = segtot[s * 128 + d]; tot += sv; if (s < seg) off += sv; } } \
    const float mid = segtot[d] + segtot[128 + d];

#define HG_CUMSUM_R(SEGOFF)                                                                                       \
    float r[16]; { float run = 0.f;                                                                               \
        _Pragma("unroll") for (int i = 0; i < 16; ++i) { run += __logf((float)fraw[i]); r[i] = run; }            \
        segtot[seg * 128 + d] = run; }                                                                            \
    __syncthreads();                                                                                              \
    float off = 0.f, tot = 0.f; { _Pragma("unroll") for (int s = 0; s < 4; ++s) { const float sv = segtot[s * 128 + d]; tot += sv; if (s < seg) off += sv; } } \
    const float mid = segtot[d] + segtot[128 + d];

__device__ __forceinline__ void hg_load_vt(const bf16* P, LAS unsigned char* VT, size_t row0, int h, int d, int seg) {
    unsigned pk[8];
#pragma unroll
    for (int i = 0; i < 8; ++i) { const unsigned lo = P[(row0 + 2 * i) * LDP + HGC_I + h * 128 + d], hi = P[(row0 + 2 * i + 1) * LDP + HGC_I + h * 128 + d]; pk[i] = lo | (hi << 16); }
    LAS v4u* dst = (LAS v4u*)(VT + d * 144 + seg * 32);
    dst[0] = (v4u){pk[0], pk[1], pk[2], pk[3]}; dst[1] = (v4u){pk[4], pk[5], pk[6], pk[7]};
}

__device__ __forceinline__ void hg_phase_a(Frame& F) {
    int tid = F.tid; OPAQUE_V(tid);
    const int d = tid & 127, seg = tid >> 7, lane = tid & 63, w = F.wave;
    LAS unsigned char* L = F.lds; LAS float* segtot = (LAS float*)(L + HA_SEG);
    const _Float16* Hf = (const _Float16*)scr_f(F, S_HF); const bf16* Hk = (const bf16*)scr_f(F, S_HK); const bf16* P = ws_bf(F, WS_P);
    float* U = scr_f(F, S_U); float* Dk = scr_f(F, S_HD);
    bf16 kraw[16]; unsigned vpk[8]; _Float16 fraw[16];
#define HA_LOAD(uu) do { const int h_ = (uu) & 7; const size_t r0_ = (size_t)((uu) >> 3) * 64 + seg * 16; \
        _Pragma("unroll") for (int i = 0; i < 16; ++i) { kraw[i] = Hk[(r0_ + i) * 1024 + h_ * 128 + d]; fraw[i] = Hf[(r0_ + i) * 1024 + h_ * 128 + d]; } \
        _Pragma("unroll") for (int i = 0; i < 8; ++i) { const unsigned lo = P[(r0_ + 2 * i) * LDP + HGC_I + h_ * 128 + d], hi = P[(r0_ + 2 * i + 1) * LDP + HGC_I + h_ * 128 + d]; vpk[i] = lo | (hi << 16); } } while (0)
    if (F.bid < NCHUNK * 8) HA_LOAD(F.bid);
    for (int u = F.bid; u < NCHUNK * 8; u += F.G) {
        const int c = u >> 3, h = u & 7; (void)c; (void)h;
        HG_CUMSUM_R(HA_SEG)
        (void)mid;
        { unsigned pk[8];
#pragma unroll
          for (int i = 0; i < 8; ++i) { const float k0 = bf2f(kraw[2 * i]) * __expf(tot - (off + r[2 * i])), k1 = bf2f(kraw[2 * i + 1]) * __expf(tot - (off + r[2 * i + 1])); pk[i] = pk2(k0, k1); }
          LAS v4u* dst = (LAS v4u*)(L + HA_KT + d * 144 + seg * 32);
          dst[0] = (v4u){pk[0], pk[1], pk[2], pk[3]}; dst[1] = (v4u){pk[4], pk[5], pk[6], pk[7]}; }
        { LAS v4u* dst = (LAS v4u*)(L + HA_VT + d * 144 + seg * 32); dst[0] = (v4u){vpk[0], vpk[1], vpk[2], vpk[3]}; dst[1] = (v4u){vpk[4], vpk[5], vpk[6], vpk[7]}; }
        if (seg == 0) Dk[(size_t)u * 128 + d] = __expf(tot);
        if (u + F.G < NCHUNK * 8) HA_LOAD(u + F.G);
        __syncthreads();
        { const int vi = w >> 1;
#pragma unroll
          for (int jj = 0; jj < 2; ++jj) { const int dj = (w & 1) * 2 + jj; f32x16 acc = zero16();
              mma32(acc, L + HA_VT + vi * 32 * 144, 144, L + HA_KT + dj * 32 * 144, 144, 4, lane);
              float* up = U + ((size_t)u * 128 + vi * 32) * 128 + dj * 32 + (lane & 31);
#pragma unroll
              for (int i = 0; i < 16; ++i) up[(size_t)ACC_ROW(i, lane) * 128] = acc[i]; } }
        __syncthreads();
    }
}
#undef HA_LOAD
__device__ __forceinline__ void hg_phase_b(Frame& F, int wg_lo) {
    if (F.bid < wg_lo) return;
    int tid = F.tid; OPAQUE_V(tid);
    const float* U = scr_f(F, S_U); const float* Dk = scr_f(F, S_HD); bf16* Sb = (bf16*)scr_f(F, S_HS);
    for (int e = (F.bid - wg_lo) * NTHREADS + tid; e < 8 * 128 * 128; e += (F.G - wg_lo) * NTHREADS) {
        const int h = e >> 14, vd = e & 16383, d = e & 127; float S = 0.f;
        for (int c0 = 0; c0 < NCHUNK; c0 += 16) { float uv[16], dk[16];
#pragma unroll
            for (int i = 0; i < 16; ++i) { const size_t un = (size_t)(c0 + i) * 8 + h; uv[i] = __builtin_nontemporal_load(U + un * 16384 + vd); dk[i] = Dk[un * 128 + d]; }
#pragma unroll
            for (int i = 0; i < 16; ++i) { const size_t un = (size_t)(c0 + i) * 8 + h; Sb[un * 16384 + vd] = (bf16)f2bf(S); S = dk[i] * S + uv[i]; } }
    }
}
__device__ __forceinline__ void hg_phase_c(Frame& F, const float* hgn) {
    int tid = F.tid; OPAQUE_V(tid);
    const int d = tid & 127, seg = tid >> 7, lane = tid & 63, w = F.wave;
    LAS unsigned char* L = F.lds; LAS float* segtot = (LAS float*)(L + HC_SEG);
    const bf16* Hq = (const bf16*)scr_f(F, S_HQ); const _Float16* Hf = (const _Float16*)scr_f(F, S_HF); const bf16* Hk = (const bf16*)scr_f(F, S_HK); const bf16* P = ws_bf(F, WS_P);
    const bf16* Sb = (const bf16*)scr_f(F, S_HS); bf16* MIX = ws_bf(F, WS_MIX);
    bf16 qraw[16], kraw[16]; unsigned vpk[8]; v4u stp[4]; _Float16 fraw[16]; v4u gq0, gq1;
#define HC_LOAD(uu) do { const int h_ = (uu) & 7; const size_t r0_ = (size_t)((uu) >> 3) * 64 + seg * 16; \
        _Pragma("unroll") for (int i = 0; i < 16; ++i) { qraw[i] = P[(r0_ + i) * LDP + HGC_Q + h_ * 128 + d]; kraw[i] = Hk[(r0_ + i) * 1024 + h_ * 128 + d]; fraw[i] = Hf[(r0_ + i) * 1024 + h_ * 128 + d]; } \
        _Pragma("unroll") for (int i = 0; i < 8; ++i) { const unsigned lo = P[(r0_ + 2 * i) * LDP + HGC_I + h_ * 128 + d], hi = P[(r0_ + 2 * i + 1) * LDP + HGC_I + h_ * 128 + d]; vpk[i] = lo | (hi << 16); } \
        { const v4u* src = (const v4u*)(Sb + (size_t)(uu) * 16384); _Pragma("unroll") for (int i = 0; i < 4; ++i) stp[i] = __builtin_nontemporal_load(src + tid + 512 * i); } \
        { const bf16* gp_ = P + ((size_t)((uu) >> 3) * 64 + (tid >> 3)) * LDP + HGC_G + h_ * 128 + (tid & 7) * 16; gq0 = *(const v4u*)gp_; gq1 = *(const v4u*)(gp_ + 8); } } while (0)
    if (F.bid < NCHUNK * 8) HC_LOAD(F.bid);
    for (int u = F.bid; u < NCHUNK * 8; u += F.G) {
        const int c = u >> 3, h = u & 7;
        HG_CUMSUM_R(HC_SEG)
#pragma unroll
        for (int i = 0; i < 16; ++i) { const int t = seg * 16 + i; const float bc = off + r[i];
            const float q = bf2f(qraw[i]), k = bf2f(kraw[i]);
            *(LAS bf16*)(L + HC_QT + t * 272 + d * 2) = (bf16)f2bf(q * exp_c(bc - mid));
            *(LAS bf16*)(L + HC_KT + t * 272 + d * 2) = (bf16)f2bf(k * exp_c(mid - bc));
            *(LAS bf16*)(L + HC_QH + t * 272 + d * 2) = (bf16)f2bf(q * __expf(bc)); }
        (void)tot;
        { LAS v4u* dst = (LAS v4u*)(L + HC_VT + d * 144 + seg * 32); dst[0] = (v4u){vpk[0], vpk[1], vpk[2], vpk[3]}; dst[1] = (v4u){vpk[4], vpk[5], vpk[6], vpk[7]}; }
#pragma unroll
        for (int i = 0; i < 4; ++i) { const int p = tid + 512 * i; *(LAS v4u*)(L + HC_ST + (p >> 4) * 272 + (p & 15) * 16) = stp[i]; }
        const v4u gc0 = gq0, gc1 = gq1;
        if (u + F.G < NCHUNK * 8) HC_LOAD(u + F.G);
        __syncthreads();
        if (w < 4) { const int ti = w >> 1, sj = w & 1; f32x16 acc = zero16();
            if (sj <= ti) mma32(acc, L + HC_QT + ti * 32 * 272, 272, L + HC_KT + sj * 32 * 272, 272, 8, lane);
            const int s = sj * 32 + (lane & 31);
#pragma unroll
            for (int i = 0; i < 16; ++i) { const int t = ti * 32 + ACC_ROW(i, lane); *(LAS bf16*)(L + HC_SC + t * 144 + s * 2) = (bf16)f2bf(s <= t ? acc[i] : 0.f); } }
        __syncthreads();
        { const int ti = w >> 2, vj = w & 3; f32x16 acc = zero16();
          mma32(acc, L + HC_QH + ti * 32 * 272, 272, L + HC_ST + vj * 32 * 272, 272, 8, lane);
          mma32(acc, L + HC_SC + ti * 32 * 144, 144, L + HC_VT + vj * 32 * 144, 144, 4, lane);
          __syncthreads();
#pragma unroll
          for (int i = 0; i < 16; ++i) *(LAS bf16*)(L + HC_QT + (ti * 32 + ACC_ROW(i, lane)) * 272 + (vj * 32 + (lane & 31)) * 2) = (bf16)f2bf(acc[i]); }
        __syncthreads();
        {
            const int tok = tid >> 3, ch = h * 128 + (tid & 7) * 16; const size_t t = (size_t)c * 64 + tok;
            float o[2][8], g[2][8], nv[2][8], out[8];
            unpack8(*(const LAS v4u*)(L + HC_QT + tok * 272 + (tid & 7) * 32), o[0]); unpack8(*(const LAS v4u*)(L + HC_QT + tok * 272 + (tid & 7) * 32 + 16), o[1]);
            unpack8(gc0, g[0]); unpack8(gc1, g[1]); load8f(hgn + ch, nv[0]); load8f(hgn + ch + 8, nv[1]);
            float ss = 0.f;
#pragma unroll
            for (int e = 0; e < 8; ++e) ss += o[0][e] * o[0][e] + o[1][e] * o[1][e];
            ss = group_sum<8>(ss); const float rn = __builtin_amdgcn_rsqf(ss * (1.f / 128.f) + EPS);
#pragma unroll
            for (int q = 0; q < 2; ++q) {
#pragma unroll
                for (int e = 0; e < 8; ++e) out[e] = o[q][e] * rn * nv[q][e] * sigmoid_f(g[q][e]);
                *(v4u*)(MIX + t * DM + ch + q * 8) = pack8(out); } }
    }
}
#undef HC_LOAD

constexpr int MA_XT = 0, MA_BT = 73728, MA_AS = 92160, MA_WS = 94208;
constexpr int MC_CI = 0, MC_BI = 17408, MC_CBR = 34816, MC_XT = 51200, MC_SCI = 88064, MC_AS = 124928, MC_DT = 126976, MC_EA = 129024;
static_assert(MC_EA + 2048 <= RING_BYTES, "Mamba LDS map");

__device__ __forceinline__ float wave_incl_scan(float x, int lane) {
    int lo = lane; asm volatile("" : "+v"(lo));
#pragma unroll
    for (int o = 1; o < 64; o <<= 1) { const float y = shfl_up_f(x, o, lo); if (lane >= o) x += y; }
    return x;
}
__device__ __forceinline__ void mb_phase_a(Frame& F) {
    int tid = F.tid; OPAQUE_V(tid);
    const int lane = tid & 63, w = F.wave;
    LAS unsigned char* L = F.lds; LAS float* as_ = (LAS float*)(L + MA_AS); LAS float* ws_ = (LAS float*)(L + MA_WS);
    const bf16* Bx = (const bf16*)scr_f(F, S_BX); const bf16* BB = (const bf16*)scr_f(F, S_BB); const float* sm = scr_f(F, S_SMALL);
    float* Um = scr_f(F, S_BU); float* osm = scr_f(F, S_OSM);
    for (int u = F.bid; u < NCHUNK * 2; u += F.G) {
        const int c = u >> 1, g = u & 1; const size_t t0 = (size_t)c * 64;
        bf16 xraw[64]; unsigned bpk[8];
        { const bf16* xp = Bx + t0 * 1024 + g * 512 + tid;
#pragma unroll
          for (int t = 0; t < 64; ++t) xraw[t] = xp[(size_t)t * 1024];
          const bf16* bp = BB + (t0 + (tid >> 7) * 16) * 256 + g * 128 + (tid & 127);
#pragma unroll
          for (int i = 0; i < 8; ++i) bpk[i] = (unsigned)bp[(size_t)(2 * i) * 256] | ((unsigned)bp[(size_t)(2 * i + 1) * 256] << 16); }
        { const int h = g * 8 + w; const float a = wave_incl_scan(sm[SM_DA + (t0 + lane) * 16 + h], lane); const float al = readlane_f(a, 63);
          as_[w * 64 + lane] = a; ws_[w * 64 + lane] = sm[SM_DT + (t0 + lane) * 16 + h] * __expf(al - a);
          if (lane == 0) osm[(size_t)c * 16 + h] = __expf(al); }
        __syncthreads();
        {
#pragma unroll
            for (int tb = 0; tb < 8; ++tb) { unsigned pk[4];
#pragma unroll
                for (int i = 0; i < 4; ++i) { const int t = tb * 8 + 2 * i; pk[i] = pk2(bf2f(xraw[t]) * ws_[w * 64 + t], bf2f(xraw[t + 1]) * ws_[w * 64 + t + 1]); }
                *(LAS v4u*)(L + MA_XT + w * 9216 + lane * 144 + tb * 16) = (v4u){pk[0], pk[1], pk[2], pk[3]}; }
            const int n = tid & 127, seg = tid >> 7;
            LAS v4u* dst = (LAS v4u*)(L + MA_BT + n * 144 + seg * 32); dst[0] = (v4u){bpk[0], bpk[1], bpk[2], bpk[3]}; dst[1] = (v4u){bpk[4], bpk[5], bpk[6], bpk[7]};
        }
        __syncthreads();
        { const int h = g * 8 + w;
#pragma unroll
          for (int pi = 0; pi < 2; ++pi)
#pragma unroll
              for (int nj = 0; nj < 4; ++nj) { f32x16 acc = zero16();
                  mma32(acc, L + MA_XT + w * 9216 + pi * 32 * 144, 144, L + MA_BT + nj * 32 * 144, 144, 4, lane);
                  float* up = Um + (((size_t)c * 16 + h) * 64 + pi * 32) * 128 + nj * 32 + (lane & 31);
#pragma unroll
                  for (int i = 0; i < 16; ++i) up[(size_t)ACC_ROW(i, lane) * 128] = acc[i]; } }
        __syncthreads();
    }
}
__device__ __forceinline__ void mb_phase_b(Frame& F) {
    int tid = F.tid; OPAQUE_V(tid);
    const float* Um = scr_f(F, S_BU); const float* osm = scr_f(F, S_OSM); bf16* Sb = (bf16*)scr_f(F, S_BS);
    for (int e = F.bid * NTHREADS + tid; e < 16 * 64 * 128; e += F.G * NTHREADS) {
        const int h = e >> 13, pn = e & 8191; float S = 0.f;
        for (int c0 = 0; c0 < NCHUNK; c0 += 8) { float uv[8], dk[8];
#pragma unroll
            for (int i = 0; i < 8; ++i) { const size_t un = (size_t)(c0 + i) * 16 + h; uv[i] = Um[un * 8192 + pn]; dk[i] = osm[un]; }
#pragma unroll
            for (int i = 0; i < 8; ++i) { const size_t un = (size_t)(c0 + i) * 16 + h; Sb[un * 8192 + pn] = (bf16)f2bf(S); S = dk[i] * S + uv[i]; } }
    }
}
__device__ __forceinline__ void mb_phase_c(Frame& F) {
    int tid = F.tid; OPAQUE_V(tid);
    const int lane = tid & 63, w = F.wave;
    LAS unsigned char* L = F.lds; LAS float* as_ = (LAS float*)(L + MC_AS); LAS float* dt_ = (LAS float*)(L + MC_DT); LAS float* ea_ = (LAS float*)(L + MC_EA);
    LAS float* cbr = (LAS float*)(L + MC_CBR);
    const bf16* Bx = (const bf16*)scr_f(F, S_BX); const bf16* BB = (const bf16*)scr_f(F, S_BB); const bf16* BC = (const bf16*)scr_f(F, S_BC); const float* sm = scr_f(F, S_SMALL);
    const bf16* Sb = (const bf16*)scr_f(F, S_BS); bf16* By = (bf16*)scr_f(F, S_BY);
    for (int u = F.bid; u < NCHUNK * 2; u += F.G) {
        const int c = u >> 1, g = u & 1; const size_t t0 = (size_t)c * 64;
        unsigned xpk[2][16];
#pragma unroll
        for (int q = 0; q < 2; ++q) { const bf16* xp = Bx + (t0 + (tid >> 8) * 32) * 1024 + g * 512 + q * 256 + (tid & 255);
#pragma unroll
            for (int i = 0; i < 16; ++i) xpk[q][i] = (unsigned)xp[(size_t)(2 * i) * 1024] | ((unsigned)xp[(size_t)(2 * i + 1) * 1024] << 16); }
        { const int h = g * 8 + w; const float a = wave_incl_scan(sm[SM_DA + (t0 + lane) * 16 + h], lane);
          as_[w * 64 + lane] = a; dt_[w * 64 + lane] = sm[SM_DT + (t0 + lane) * 16 + h]; ea_[w * 64 + lane] = __expf(a); }
        { const int n = tid & 127, seg = tid >> 7; const bf16* cp = BC + (t0 + seg * 16) * 256 + g * 128 + n; const bf16* bp = BB + (t0 + seg * 16) * 256 + g * 128 + n;
#pragma unroll
          for (int i = 0; i < 16; ++i) { const int t = seg * 16 + i;
              *(LAS bf16*)(L + MC_CI + t * 272 + n * 2) = cp[(size_t)i * 256]; *(LAS bf16*)(L + MC_BI + t * 272 + n * 2) = bp[(size_t)i * 256]; } }
        __syncthreads();
        if (w < 4) { const int ti = w >> 1, sj = w & 1; f32x16 acc = zero16();
            if (sj <= ti) mma32(acc, L + MC_CI + ti * 32 * 272, 272, L + MC_BI + sj * 32 * 272, 272, 8, lane);
#pragma unroll
            for (int i = 0; i < 16; ++i) cbr[(w * 64 + lane) * 16 + i] = acc[i]; }
#pragma unroll
        for (int q = 0; q < 2; ++q) {
            { const int ch = tid & 255, half = tid >> 8;
#pragma unroll
              for (int tb = 0; tb < 4; ++tb) *(LAS v4u*)(L + MC_XT + (ch >> 6) * 9216 + (ch & 63) * 144 + half * 64 + tb * 16) = (v4u){xpk[q][4 * tb], xpk[q][4 * tb + 1], xpk[q][4 * tb + 2], xpk[q][4 * tb + 3]}; }
            __syncthreads();
            const int hl = w & 3, r = q * 4 + hl, ti = w >> 2, h = g * 8 + r;
#pragma unroll
            for (int sj = 0; sj < 2; ++sj) { const int s = sj * 32 + (lane & 31); const float a_s = as_[r * 64 + s], dt_s = dt_[r * 64 + s];
#pragma unroll
                for (int i = 0; i < 16; ++i) { const int t = ti * 32 + ACC_ROW(i, lane); float val = 0.f;
                    if (sj <= ti && s <= t) val = cbr[((ti * 2 + sj) * 64 + lane) * 16 + i] * __expf(as_[r * 64 + t] - a_s) * dt_s;
                    *(LAS bf16*)(L + MC_SCI + hl * 9216 + t * 144 + s * 2) = (bf16)f2bf(val); } }
            LDS_WAIT();
            f32x16 ai[2], ae[2];
#pragma unroll
            for (int pj = 0; pj < 2; ++pj) { ai[pj] = zero16(); ae[pj] = zero16();
                mma32(ai[pj], L + MC_SCI + hl * 9216 + ti * 32 * 144, 144, L + MC_XT + hl * 9216 + pj * 32 * 144, 144, 4, lane);
                mma32_gb<8>(ae[pj], L + MC_CI + ti * 32 * 272, 272, (const unsigned char*)(Sb + (((size_t)c * 16 + h) * 64 + pj * 32) * 128), 256, lane); }
#pragma unroll
            for (int pj = 0; pj < 2; ++pj) {
#pragma unroll
                for (int i = 0; i < 16; ++i) { const int tr = ACC_ROW(i, lane); ai[pj][i] += ea_[r * 64 + ti * 32 + tr] * ae[pj][i]; }
                store_tile_bf16(L + MC_SCI + hl * 9216 + ti * 32 * 144, ai[pj], By + (t0 + ti * 32) * 1024 + h * 64 + pj * 32, 1024, lane); }
            __syncthreads();
        }
    }
}

constexpr int LA_VT = 0, LA_KT = 41472, LA_WS = 59904;
constexpr int LC_QI = 0, LC_QR = 17408, LC_KI = 34816, LC_VT = 52224, LC_PM = 93696, LC_ROWF = 102912, LC_COLF = 103168, LC_WI = 103424;
constexpr size_t OSM_BL = 4096, OSM_ML = 8192, OSM_MC = 12288;
constexpr size_t SM_EM = 3 * MiB / 4;
constexpr int ML_ROWS = 288;

__device__ __forceinline__ float wave_incl_scan_max(float x, int lane) {
    int lo = lane; asm volatile("" : "+v"(lo));
#pragma unroll
    for (int o = 1; o < 64; o <<= 1) { const float y = shfl_up_f(x, o, lo); if (lane >= o) x = fmaxf(x, y); }
    return x;
}
__device__ __forceinline__ float wave_max(float v) {
    v = fmaxf(v, xshfl<1>(v)); v = fmaxf(v, xshfl<2>(v)); v = fmaxf(v, xshfl<4>(v)); v = fmaxf(v, xshfl<8>(v)); v = fmaxf(v, xshfl<16>(v)); v = fmaxf(v, xshfl<32>(v));
    return v;
}
__device__ __forceinline__ void ml_vt_load(const bf16* P, unsigned (&pk)[16], size_t t0, int h, int tid) {
    const int v = tid & 255, half = tid >> 8; const bf16* vp = P + (t0 + half * 32) * LDP + MLC_V + h * 256 + v;
#pragma unroll
    for (int i = 0; i < 16; ++i) pk[i] = (unsigned)vp[(size_t)(2 * i) * LDP] | ((unsigned)vp[(size_t)(2 * i + 1) * LDP] << 16);
}
__device__ __forceinline__ void ml_vt_store(LAS unsigned char* VT, const unsigned (&pk)[16], int tid) {
    const int v = tid & 255, half = tid >> 8;
#pragma unroll
    for (int tb = 0; tb < 4; ++tb) *(LAS v4u*)(VT + v * 144 + half * 64 + tb * 16) = (v4u){pk[4 * tb], pk[4 * tb + 1], pk[4 * tb + 2], pk[4 * tb + 3]};
    if (tid < 32) { const unsigned one2 = (tid == 0) ? 0x3F803F80u : 0u;
#pragma unroll
        for (int i = 0; i < 8; ++i) *(LAS v4u*)(VT + (256 + tid) * 144 + i * 16) = (v4u){one2, one2, one2, one2}; }
}
__device__ __forceinline__ void ml_phase_a(Frame& F) {
    int tid = F.tid; OPAQUE_V(tid);
    const int lane = tid & 63, w = F.wave;
    LAS unsigned char* L = F.lds; LAS float* ws_ = (LAS float*)(L + LA_WS);
    const bf16* Mk = (const bf16*)scr_f(F, S_MK); const float* sm = scr_f(F, S_SMALL); const bf16* P = ws_bf(F, WS_P);
    float* U = scr_f(F, S_U); float* osm = scr_f(F, S_OSM);
    unsigned vpk[16]; bf16 kraw[16]; float lf = 0.f, ip = 0.f;
#define MLA_LOAD(uu) do { const int h_ = (uu) & 3; const size_t t0_ = (size_t)((uu) >> 2) * 64; ml_vt_load(P, vpk, t0_, h_, tid); \
        { const bf16* kp = Mk + (t0_ + (tid >> 7) * 16) * 512 + h_ * 128 + (tid & 127); _Pragma("unroll") for (int i = 0; i < 16; ++i) kraw[i] = kp[(size_t)i * 512]; } \
        if (w == 0) { lf = sm[SM_F + (t0_ + lane) * 4 + h_]; ip = sm[SM_EI + (t0_ + lane) * 4 + h_]; } } while (0)
    if (F.bid < NCHUNK * 4) MLA_LOAD(F.bid);
    for (int u = F.bid; u < NCHUNK * 4; u += F.G) {
        if (w == 0) {
            const float bc = wave_incl_scan(lf, lane); const float bl = readlane_f(bc, 63); const float src = bl - bc + ip; const float ml = wave_max(src);
            ws_[lane] = __expf(src - ml);
            if (lane == 0) { osm[OSM_BL + u] = bl; osm[OSM_ML + u] = ml; } }
        __syncthreads();
        { const int d = tid & 127, seg = tid >> 7; unsigned pk[8];
#pragma unroll
          for (int i = 0; i < 8; ++i) pk[i] = pk2(bf2f(kraw[2 * i]) * ws_[seg * 16 + 2 * i], bf2f(kraw[2 * i + 1]) * ws_[seg * 16 + 2 * i + 1]);
          LAS v4u* dst = (LAS v4u*)(L + LA_KT + d * 144 + seg * 32); dst[0] = (v4u){pk[0], pk[1], pk[2], pk[3]}; dst[1] = (v4u){pk[4], pk[5], pk[6], pk[7]}; }
        ml_vt_store(L + LA_VT, vpk, tid);
        if (u + F.G < NCHUNK * 4) MLA_LOAD(u + F.G);
        __syncthreads();
        for (int idx = w; idx < 36; idx += 8) { const int vi = idx >> 2, dj = idx & 3; f32x16 acc = zero16();
            mma32(acc, L + LA_VT + vi * 32 * 144, 144, L + LA_KT + dj * 32 * 144, 144, 4, lane);
            float* up = U + ((size_t)u * ML_ROWS + vi * 32) * 128 + dj * 32 + (lane & 31);
#pragma unroll
            for (int i = 0; i < 16; ++i) up[(size_t)ACC_ROW(i, lane) * 128] = acc[i]; }
        __syncthreads();
    }
}
#undef MLA_LOAD
__device__ __forceinline__ void ml_phase_b(Frame& F) {
    int tid = F.tid; OPAQUE_V(tid);
    const float* U = scr_f(F, S_U); float* osm = scr_f(F, S_OSM); bf16* Sb = (bf16*)scr_f(F, S_MS);
    for (int e = F.bid * NTHREADS + tid; e < 4 * ML_ROWS * 128; e += F.G * NTHREADS) {
        const int h = e / (ML_ROWS * 128), vd = e % (ML_ROWS * 128); float S = 0.f, m = 0.f;
        for (int c0 = 0; c0 < NCHUNK; c0 += 8) { float uv[8], bl[8], ml[8];
#pragma unroll
            for (int i = 0; i < 8; ++i) { const size_t un = (size_t)(c0 + i) * 4 + h; uv[i] = U[un * (ML_ROWS * 128) + vd]; bl[i] = osm[OSM_BL + un]; ml[i] = osm[OSM_ML + un]; }
#pragma unroll
            for (int i = 0; i < 8; ++i) { const size_t un = (size_t)(c0 + i) * 4 + h; Sb[un * (ML_ROWS * 128) + vd] = (bf16)f2bf(S); if (vd == 0) osm[OSM_MC + un] = m;
                const float mn = fmaxf(bl[i] + m, ml[i]); S = __expf(bl[i] + m - mn) * S + __expf(ml[i] - mn) * uv[i]; m = mn; } }
    }
}
__device__ __forceinline__ void ml_phase_c(Frame& F) {
    int tid = F.tid; OPAQUE_V(tid);
    const int lane = tid & 63, w = F.wave;
    LAS unsigned char* L = F.lds; LAS float* rowf = (LAS float*)(L + LC_ROWF); LAS float* colf = (LAS float*)(L + LC_COLF); LAS float* wi_ = (LAS float*)(L + LC_WI);
    const bf16* Mq = (const bf16*)scr_f(F, S_MQ); const bf16* Mk = (const bf16*)scr_f(F, S_MK); float* sm = scr_f(F, S_SMALL); const bf16* P = ws_bf(F, WS_P);
    const float* osm = scr_f(F, S_OSM); const bf16* Sb = (const bf16*)scr_f(F, S_MS); bf16* Mnum = (bf16*)scr_f(F, S_MNUM);
    LAS unsigned char* blk = L + 104448 + w * 2048;
    unsigned vpk[16]; bf16 qraw[16], kraw[16]; float lf = 0.f, ip = 0.f, mc = 0.f;
#define MLC_LOAD(uu) do { const int h_ = (uu) & 3; const size_t t0_ = (size_t)((uu) >> 2) * 64; ml_vt_load(P, vpk, t0_, h_, tid); \
        { const bf16* qp = Mq + (t0_ + (tid >> 7) * 16) * 512 + h_ * 128 + (tid & 127); const bf16* kp = Mk + (t0_ + (tid >> 7) * 16) * 512 + h_ * 128 + (tid & 127); \
          _Pragma("unroll") for (int i = 0; i < 16; ++i) { qraw[i] = qp[(size_t)i * 512]; kraw[i] = kp[(size_t)i * 512]; } } \
        if (w == 0) { lf = sm[SM_F + (t0_ + lane) * 4 + h_]; ip = sm[SM_EI + (t0_ + lane) * 4 + h_]; mc = osm[OSM_MC + (uu)]; } } while (0)
    if (F.bid < NCHUNK * 4) MLC_LOAD(F.bid);
    for (int u = F.bid; u < NCHUNK * 4; u += F.G) {
        const int c = u >> 2, h = u & 3; const size_t t0 = (size_t)c * 64; (void)c;
        if (w == 0) {
            const float bc = wave_incl_scan(lf, lane); const float us = ip - bc; const float pm = wave_incl_scan_max(us, lane);
            const float mt = bc + fmaxf(mc, pm);
            rowf[lane] = bc - mt; colf[lane] = us; wi_[lane] = __expf(bc + mc - mt);
            sm[SM_EM + (t0 + lane) * 4 + h] = __expf(-mt); }
        __syncthreads();
        { const int d = tid & 127, seg = tid >> 7;
#pragma unroll
          for (int i = 0; i < 16; ++i) { const int t = seg * 16 + i; const float q = bf2f(qraw[i]);
              *(LAS bf16*)(L + LC_QR + t * 272 + d * 2) = (bf16)f2bf(q); *(LAS bf16*)(L + LC_QI + t * 272 + d * 2) = (bf16)f2bf(q * wi_[t]);
              *(LAS bf16*)(L + LC_KI + t * 272 + d * 2) = kraw[i]; } }
        ml_vt_store(L + LC_VT, vpk, tid);
        if (u + F.G < NCHUNK * 4) MLC_LOAD(u + F.G);
        __syncthreads();
        if (w < 4) { const int ti = w >> 1, sj = w & 1; f32x16 acc = zero16();
            if (sj <= ti) mma32(acc, L + LC_QR + ti * 32 * 272, 272, L + LC_KI + sj * 32 * 272, 272, 8, lane);
            const int s = sj * 32 + (lane & 31); const float cf = colf[s];
#pragma unroll
            for (int i = 0; i < 16; ++i) { const int t = ti * 32 + ACC_ROW(i, lane); *(LAS bf16*)(L + LC_PM + t * 144 + s * 2) = (bf16)f2bf(s <= t ? acc[i] * __expf(fminf(rowf[t] + cf, 0.f)) : 0.f); } }
        __syncthreads();
        for (int idx = w; idx < 18; idx += 8) { const int ti = idx / 9, vj = idx % 9; f32x16 acc = zero16();
            mma32_gb<8>(acc, L + LC_QI + ti * 32 * 272, 272, (const unsigned char*)(Sb + ((size_t)u * ML_ROWS + vj * 32) * 128), 256, lane);
            mma32(acc, L + LC_PM + ti * 32 * 144, 144, L + LC_VT + vj * 32 * 144, 144, 4, lane);
            if (vj < 8) store_tile_bf16(blk, acc, Mnum + (t0 + ti * 32) * 1024 + h * 256 + vj * 32, 1024, lane);
            else if ((lane & 31) == 0) {
#pragma unroll
                for (int i = 0; i < 16; ++i) sm[SM_DEN + (t0 + ti * 32 + ACC_ROW(i, lane)) * 4 + h] = acc[i]; } }
        __syncthreads();
    }
}
#undef MLC_LOAD

constexpr int RIMG = 9216;
constexpr int RW_SEG = 14 * RIMG, RW_EGL = RW_SEG + 2048 - 256;
static_assert(RW_SEG + 2048 <= RING_BYTES, "RWKV LDS map");
#define RW_IMG(k) (L + (k) * RIMG)

__device__ __forceinline__ void rw_store_T(LAS unsigned char* img, const f32x16& a, int rowbase, int col, int lane) {
#pragma unroll
    for (int g = 0; g < 4; ++g) { v2u o; o.x = pk2(a[4 * g], a[4 * g + 1]); o.y = pk2(a[4 * g + 2], a[4 * g + 3]);
        *(LAS v2u*)(img + col * 144 + (rowbase + 8 * g + 4 * (lane >> 5)) * 2) = o; }
}
__device__ __forceinline__ void rw_store_N(LAS unsigned char* img, const f32x16& a, int rowbase, int col, int lane) {
#pragma unroll
    for (int i = 0; i < 16; ++i) *(LAS bf16*)(img + (rowbase + ACC_ROW(i, lane)) * 144 + col * 2) = (bf16)f2bf(a[i]);
}
__device__ __forceinline__ void rw_phase_a(Frame& F) {
    int tid = F.tid; OPAQUE_V(tid);
    const int lane = tid & 63, w = F.wave, n = lane, seg = w;
    LAS unsigned char* L = F.lds; LAS float* segtot = (LAS float*)(L + RW_SEG); LAS float* egl = (LAS float*)(L + RW_EGL);
    const v4u* RA = (const v4u*)scr_f(F, S_RR); const v2u* RB = (const v2u*)scr_f(F, S_RK2);
    bf16* MQ = (bf16*)scr_f(F, S_RMQ); float* RN = scr_f(F, S_RN); float* ROL = scr_f(F, S_ROL);
    const int ti = w >> 2, cj = (w & 3) ^ ((w >> 2) << 1), cl = lane & 31;
    float lw[8]; bf16 qkk[8], qkka[8], qk2[8], qrr[8], qvv[8];
#define RW_PUT2(j0, A, B) do { qrr[j0] = (bf16)(A.x & 0xffffu); qrr[j0 + 1] = (bf16)(A.x >> 16); qk2[j0] = (bf16)(A.y & 0xffffu); qk2[j0 + 1] = (bf16)(A.y >> 16); \
        qkk[j0] = (bf16)(A.z & 0xffffu); qkk[j0 + 1] = (bf16)(A.z >> 16); qkka[j0] = (bf16)(A.w & 0xffffu); qkka[j0 + 1] = (bf16)(A.w >> 16); \
        lw[j0] = (float)__builtin_bit_cast(_Float16, (unsigned short)(B.x & 0xffffu)); lw[j0 + 1] = (float)__builtin_bit_cast(_Float16, (unsigned short)(B.x >> 16)); \
        qvv[j0] = (bf16)(B.y & 0xffffu); qvv[j0 + 1] = (bf16)(B.y >> 16); } while (0)
#define RW_LOAD(uu) do { const size_t rc_ = ((((size_t)((uu) >> 4) * 2 + (seg >> 2)) * 16 + ((uu) & 15)) * 2 + (n >> 5)) * 512 + (seg & 3) * 128 + (n & 31); \
        const v4u A00 = __builtin_nontemporal_load(RA + rc_), A10 = __builtin_nontemporal_load(RA + rc_ + 64), A01 = __builtin_nontemporal_load(RA + rc_ + 32), A11 = __builtin_nontemporal_load(RA + rc_ + 96); const v2u B00 = __builtin_nontemporal_load(RB + rc_), B10 = __builtin_nontemporal_load(RB + rc_ + 64), B01 = __builtin_nontemporal_load(RB + rc_ + 32), B11 = __builtin_nontemporal_load(RB + rc_ + 96); \
        RW_PUT2(0, A00, B00); RW_PUT2(2, A10, B10); RW_PUT2(4, A01, B01); RW_PUT2(6, A11, B11); } while (0)
    if (F.bid < NCHUNK * 16) RW_LOAD(F.bid);
    for (int u = F.bid; u < NCHUNK * 16; u += F.G) {
        float r[8];
        { float run = 0.f;
#pragma unroll
            for (int i = 0; i < 8; ++i) { run += lw[i]; r[i] = run; }
            segtot[seg * 64 + n] = run; }
        __syncthreads();
        float off = 0.f, tot = 0.f;
#pragma unroll
        for (int s = 0; s < 8; ++s) { const float sv = segtot[s * 64 + n]; tot += sv; if (s < seg) off += sv; }
        { unsigned bh[4], kh[4], vt[4];
#pragma unroll
          for (int i = 0; i < 8; i += 2) { float bhv[2], khv[2], vv[2];
#pragma unroll
              for (int e = 0; e < 2; ++e) { const int ii = i + e, t = seg * 8 + ii;
                  const float cum = off + r[ii], cp = cum - lw[ii]; const float kk = bf2f(qkk[ii]), kka = bf2f(qkka[ii]), k2 = bf2f(qk2[ii]), rr = bf2f(qrr[ii]);
                  const float eneg = __expf(-cum), eh = __expf(tot - cum);
                  *(LAS bf16*)(RW_IMG(0) + t * 144 + n * 2) = (bf16)f2bf(-kk * __expf(cp));
                  *(LAS bf16*)(RW_IMG(1) + t * 144 + n * 2) = (bf16)f2bf(rr * __expf(cum));
                  *(LAS bf16*)(RW_IMG(2) + t * 144 + n * 2) = (bf16)f2bf(kka * eneg);
                  *(LAS bf16*)(RW_IMG(3) + t * 144 + n * 2) = (bf16)f2bf(k2 * eneg);
                  bhv[e] = kka * eh; khv[e] = k2 * eh; vv[e] = bf2f(qvv[ii]); }
              bh[i >> 1] = pk2(bhv[0], bhv[1]); kh[i >> 1] = pk2(khv[0], khv[1]); vt[i >> 1] = pk2(vv[0], vv[1]); }
          *(LAS v4u*)(RW_IMG(4) + n * 144 + seg * 16) = (v4u){bh[0], bh[1], bh[2], bh[3]};
          *(LAS v4u*)(RW_IMG(5) + n * 144 + seg * 16) = (v4u){kh[0], kh[1], kh[2], kh[3]};
          *(LAS v4u*)(RW_IMG(6) + n * 144 + seg * 16) = (v4u){vt[0], vt[1], vt[2], vt[3]}; }
        if (u + F.G < NCHUNK * 16) RW_LOAD(u + F.G);
        __syncthreads();
        if (seg == 7) egl[n] = __expf(tot);
        { const int pidx = w >> 1, sj = (w ^ (w >> 2)) & 1; LAS unsigned char* Ai = (pidx < 2) ? RW_IMG(0) : RW_IMG(1); LAS unsigned char* Bi = (pidx & 1) ? RW_IMG(3) : RW_IMG(2);
          LAS unsigned char* dst = pidx == 0 ? RW_IMG(7) : (pidx == 1 ? RW_IMG(9) : (pidx == 2 ? RW_IMG(10) : RW_IMG(11)));
#pragma unroll
          for (int t2 = 0; t2 < 2; ++t2) { f32x16 acc = zero16();
              if (sj <= t2) mma32(acc, Ai + t2 * 32 * 144, 144, Bi + sj * 32 * 144, 144, 4, lane);
              const int s = sj * 32 + cl;
#pragma unroll
              for (int i = 0; i < 16; ++i) { const int t = t2 * 32 + ACC_ROW(i, lane); const bool keep = (pidx < 2) ? (s < t) : (s <= t); acc[i] = keep ? acc[i] : 0.f; }
              rw_store_N(dst, acc, t2 * 32, s, lane);
              if (pidx == 0) rw_store_T(RW_IMG(8), acc, t2 * 32, s, lane); } }
        __syncthreads();
        f32x16 X;
        if (cj < 2) {
#pragma unroll
            for (int i = 0; i < 16; ++i) X[i] = bf2f(*(const LAS bf16*)(RW_IMG(0) + (ti * 32 + ACC_ROW(i, lane)) * 144 + (cj * 32 + cl) * 2));
        } else { X = zero16(); mma32(X, RW_IMG(9) + ti * 32 * 144, 144, RW_IMG(6) + (cj - 2) * 32 * 144, 144, 4, lane); }
        rw_store_T(RW_IMG(2), X, ti * 32, cj * 32 + cl, lane);
        __syncthreads();
#pragma unroll
        for (int st = 0; st < 6; ++st) {
            LAS unsigned char* Pc = (st & 1) ? RW_IMG(0) : RW_IMG(7); LAS unsigned char* PTc = (st & 1) ? RW_IMG(9) : RW_IMG(8); LAS unsigned char* XTc = (st & 1) ? RW_IMG(12) : RW_IMG(2);
            LAS unsigned char* Pn = (st & 1) ? RW_IMG(7) : RW_IMG(0); LAS unsigned char* PTn = (st & 1) ? RW_IMG(8) : RW_IMG(9); LAS unsigned char* XTn = (st & 1) ? RW_IMG(2) : RW_IMG(12);
            mma32(X, Pc + ti * 32 * 144, 144, XTc + cj * 32 * 144, 144, 4, lane);
            if (st < 5 && cj < 2) { f32x16 sq = zero16(); mma32(sq, Pc + ti * 32 * 144, 144, PTc + cj * 32 * 144, 144, 4, lane);
                rw_store_N(Pn, sq, ti * 32, cj * 32 + cl, lane); rw_store_T(PTn, sq, ti * 32, cj * 32 + cl, lane); }
            rw_store_T(XTn, X, ti * 32, cj * 32 + cl, lane);
            __syncthreads();
        }
        { f32x16 acc = zero16();
          mma32(acc, RW_IMG(4) + ti * 32 * 144, 144, RW_IMG(2) + cj * 32 * 144, 144, 4, lane);
          if (cj >= 2) mma32(acc, RW_IMG(5) + ti * 32 * 144, 144, RW_IMG(6) + (cj - 2) * 32 * 144, 144, 4, lane);
          if (cj < 2) { bf16* mt = MQ + (size_t)u * 8192;
#pragma unroll
              for (int i = 0; i < 16; ++i) { const int k = ti * 32 + ACC_ROW(i, lane), kp = cj * 32 + cl; const float val = acc[i] + (k == kp ? egl[k] : 0.f); mt[k * 64 + kp] = (bf16)f2bf(val); } }
          else { float* nt = RN + (size_t)u * 4096 + (ti * 2 + (cj - 2)) * 1024;
#pragma unroll
              for (int q4 = 0; q4 < 4; ++q4) *(f32x4*)(nt + (q4 * 64 + lane) * 4) = (f32x4){acc[4 * q4], acc[4 * q4 + 1], acc[4 * q4 + 2], acc[4 * q4 + 3]}; } }
        { f32x16 acc;
          if (cj < 2) {
#pragma unroll
              for (int i = 0; i < 16; ++i) acc[i] = bf2f(*(const LAS bf16*)(RW_IMG(1) + (ti * 32 + ACC_ROW(i, lane)) * 144 + (cj * 32 + cl) * 2));
          } else acc = zero16();
          mma32(acc, RW_IMG(10) + ti * 32 * 144, 144, RW_IMG(2) + cj * 32 * 144, 144, 4, lane);
          if (cj >= 2) mma32(acc, RW_IMG(11) + ti * 32 * 144, 144, RW_IMG(6) + (cj - 2) * 32 * 144, 144, 4, lane);
          if (cj < 2) { bf16* qe = MQ + (size_t)u * 8192 + 4096;
#pragma unroll
              for (int i = 0; i < 16; ++i) qe[(ti * 32 + ACC_ROW(i, lane)) * 64 + cj * 32 + cl] = (bf16)f2bf(acc[i]); }
          else { v4u* ol = (v4u*)ROL + (size_t)u * 512 + (ti * 2 + (cj - 2)) * 128;
#pragma unroll
              for (int q2 = 0; q2 < 2; ++q2) ol[q2 * 64 + lane] = (v4u){pk2(acc[8 * q2], acc[8 * q2 + 1]), pk2(acc[8 * q2 + 2], acc[8 * q2 + 3]), pk2(acc[8 * q2 + 4], acc[8 * q2 + 5]), pk2(acc[8 * q2 + 6], acc[8 * q2 + 7])}; } }
        __syncthreads();
    }
#undef RW_LOAD
#undef RW_PUT2
}
constexpr int RB_SLOT = 16384, RB_N = 8192;
struct RbOps { bf16x8v a[8]; f32x4 n[8]; };
__device__ __forceinline__ void rb_ops_load(RbOps& o, const LAS unsigned char* sl, int cl, int hh, int lane) {
#pragma unroll
    for (int f = 0; f < 8; ++f) o.a[f] = *(const LAS bf16x8v*)(sl + ((f * 2 + hh) * 32 + cl) * 16);
#pragma unroll
    for (int q = 0; q < 8; ++q) o.n[q] = *(const LAS f32x4*)(sl + RB_N + (q * 64 + lane) * 16);
}
__device__ __forceinline__ void rw_phase_b(Frame& F) {
    if (F.bid >= 32) return;
    int lane = F.lane; OPAQUE_V(lane);
    const int w = F.wave, head = F.bid >> 1, vh = F.bid & 1, cl = lane & 31, hh = lane >> 5;
    LAS unsigned char* L = F.lds;
    const bf16* MQ = (const bf16*)scr_f(F, S_RMQ); const float* RN = scr_f(F, S_RN); bf16* RS = (bf16*)scr_f(F, S_RS);
    constexpr int RND = 4, NR = NCHUNK / RND;
    static_assert(NCHUNK % (2 * RND) == 0 && 2 * RND * RB_SLOT <= RING_BYTES, "RWKV chain ring");
    if (w == 0) {
        f32x16 X0 = zero16(), X1 = zero16();
        __builtin_amdgcn_s_setprio(3);
        lds_barrier();
        for (int r = 0; r < NR; ++r) {
            const LAS unsigned char* buf = L + (r & 1) * RND * RB_SLOT;
            RbOps cur; rb_ops_load(cur, buf, cl, hh, lane);
#pragma unroll
            for (int sidx = 0; sidx < RND; ++sidx) { const int c = RND * r + sidx;
                RbOps nxt;
                if (sidx < RND - 1) rb_ops_load(nxt, buf + (sidx + 1) * RB_SLOT, cl, hh, lane);
                __builtin_amdgcn_sched_barrier(0);
                { const size_t u = (size_t)c * 16 + head;
                    unsigned p0[8], p1[8];
#pragma unroll
                    for (int m = 0; m < 8; ++m) { p0[m] = pk2(X0[2 * m], X0[2 * m + 1]); p1[m] = pk2(X1[2 * m], X1[2 * m + 1]); }
                    bf16* rs = RS + u * 4096 + (vh * 32 + cl) * 64 + 4 * hh;
#pragma unroll
                    for (int g = 0; g < 4; ++g) { *(v2u*)(rs + 8 * g) = (v2u){p0[2 * g], p0[2 * g + 1]}; *(v2u*)(rs + 32 + 8 * g) = (v2u){p1[2 * g], p1[2 * g + 1]}; }
                    bf16x8v b[4];
                    b[0] = __builtin_bit_cast(bf16x8v, ((v4u){p0[0], p0[1], p0[2], p0[3]})); b[1] = __builtin_bit_cast(bf16x8v, ((v4u){p0[4], p0[5], p0[6], p0[7]}));
                    b[2] = __builtin_bit_cast(bf16x8v, ((v4u){p1[0], p1[1], p1[2], p1[3]})); b[3] = __builtin_bit_cast(bf16x8v, ((v4u){p1[4], p1[5], p1[6], p1[7]}));
                    f32x16 y0, y1;
#pragma unroll
                    for (int q4 = 0; q4 < 4; ++q4) {
#pragma unroll
                        for (int e = 0; e < 4; ++e) { y0[4 * q4 + e] = cur.n[q4][e]; y1[4 * q4 + e] = cur.n[4 + q4][e]; } }
#pragma unroll
                    for (int f = 0; f < 4; ++f) {
                        y0 = __builtin_amdgcn_mfma_f32_32x32x16_bf16(cur.a[f], b[f], y0, 0, 0, 0);
                        y1 = __builtin_amdgcn_mfma_f32_32x32x16_bf16(cur.a[4 + f], b[f], y1, 0, 0, 0); }
                    X0 = y0; X1 = y1; }
                if (sidx < RND - 1) cur = nxt; }
            lds_barrier();
        }
        __builtin_amdgcn_s_setprio(0);
    } else {
        v4u rmA[8], rmB[8]; f32x4 rnA[8], rnB[8];
#define RB_LOAD(r, RM, RN_) do { if ((r) < NR && w <= RND) { const size_t u_ = (size_t)(RND * (r) + w - 1) * 16 + head; \
        _Pragma("unroll") for (int i = 0; i < 8; ++i) { const int p = lane + 64 * i; RM[i] = *(const v4u*)(MQ + u_ * 8192 + (p >> 3) * 64 + (p & 7) * 8); \
            RN_[i] = *(const f32x4*)(RN + u_ * 4096 + ((i >> 2) * 2 + vh) * 1024 + ((i & 3) * 64 + lane) * 4); } } } while (0)
#define RB_PUT(r, RM, RN_) do { if ((r) < NR && w <= RND) { LAS unsigned char* sl = L + (((r) & 1) * RND + w - 1) * RB_SLOT; \
        _Pragma("unroll") for (int i = 0; i < 8; ++i) { const int p = lane + 64 * i, k = p >> 3, q8 = p & 7; \
            LAS unsigned char* fb = sl + ((((((k >> 5) * 2 + (q8 >> 2)) * 2 + ((q8 >> 1) & 1)) * 2) * 32 + (k & 31)) * 16) + (q8 & 1) * 8;     \
            *(LAS v2u*)fb = (v2u){RM[i].x, RM[i].y}; *(LAS v2u*)(fb + 512) = (v2u){RM[i].z, RM[i].w}; \
            *(LAS f32x4*)(sl + RB_N + (i * 64 + lane) * 16) = RN_[i]; } } } while (0)
        RB_LOAD(0, rmA, rnA); RB_PUT(0, rmA, rnA);
        RB_LOAD(1, rmA, rnA); RB_LOAD(2, rmB, rnB);
        lds_barrier();
        for (int r = 0; r < NR; r += 2) {
            RB_PUT(r + 1, rmA, rnA); RB_LOAD(r + 3, rmA, rnA);
            lds_barrier();
            RB_PUT(r + 2, rmB, rnB); RB_LOAD(r + 4, rmB, rnB);
            lds_barrier();
        }
#undef RB_LOAD
#undef RB_PUT
    }
}
__device__ __forceinline__ void rw_phase_c(Frame& F, const Args& args, int layer) {
    int tid = F.tid; OPAQUE_V(tid);
    const int lane = tid & 63, w = F.wave, cl = lane & 31, hh = lane >> 5, ti = (w >> 1) & 1, vj = w & 1, j = layer >> 1;
    const bf16* MQ = (const bf16*)scr_f(F, S_RMQ); const float* ROL = scr_f(F, S_ROL); const bf16* RS = (const bf16*)scr_f(F, S_RS);
    const bf16* Rgate = (const bf16*)scr_f(F, S_RGATE); const float* Rbs = scr_f(F, S_RBONUS); const bf16* Rv = (const bf16*)scr_f(F, S_RV); bf16* MIX = ws_bf(F, WS_MIX);
    const float* lnw = F_IN(17) + j * 1024; const float* lnb = F_IN(18) + j * 1024;
    LAS unsigned char* L = F.lds; int par = 0;
    v4u pn[2]; bf16x8v pa[4], pb[4];
#define RC_LOAD(ubb) do { const int u_ = (ubb) + (w >> 2); const v4u* ol_ = (const v4u*)ROL + (size_t)u_ * 512 + (ti * 2 + vj) * 128; \
        pn[0] = __builtin_nontemporal_load(ol_ + lane); pn[1] = __builtin_nontemporal_load(ol_ + 64 + lane); \
        const bf16* ap_ = MQ + (size_t)u_ * 8192 + 4096 + (ti * 32 + cl) * 64 + 8 * hh; const bf16* bp_ = RS + (size_t)u_ * 4096 + (vj * 32 + cl) * 64 + 8 * hh; \
        _Pragma("unroll") for (int ks = 0; ks < 4; ++ks) { pa[ks] = *(const bf16x8v*)(ap_ + ks * 16); pb[ks] = *(const bf16x8v*)(bp_ + ks * 16); } } while (0)
    if (F.bid * 2 < NCHUNK * 16) RC_LOAD(F.bid * 2);
    for (int ub = F.bid * 2; ub < NCHUNK * 16; ub += F.G * 2) {
        const int pu = ub + (tid >> 8), tok = (tid >> 2) & 63, hd = pu & 15, chn = hd * 64 + (tid & 3) * 16; const size_t tt = (size_t)(pu >> 4) * 64 + tok;
        const v4u ga0 = *(const v4u*)(Rgate + tt * 1024 + chn), ga1 = *(const v4u*)(Rgate + tt * 1024 + chn + 8), bv0 = *(const v4u*)(Rv + tt * 1024 + chn), bv1 = *(const v4u*)(Rv + tt * 1024 + chn + 8);
        const float bsc = Rbs[tt * 16 + hd];
        f32x16 acc; bf16x8v ca[4], cb[4];
#pragma unroll
        for (int q2 = 0; q2 < 2; ++q2) {
#pragma unroll
            for (int e = 0; e < 4; ++e) { const unsigned pr_ = pn[q2][e]; acc[8 * q2 + 2 * e] = __builtin_bit_cast(float, pr_ << 16); acc[8 * q2 + 2 * e + 1] = __builtin_bit_cast(float, pr_ & 0xffff0000u); } }
#pragma unroll
        for (int ks = 0; ks < 4; ++ks) { ca[ks] = pa[ks]; cb[ks] = pb[ks]; }
        if (ub + F.G * 2 < NCHUNK * 16) RC_LOAD(ub + F.G * 2);
#pragma unroll
        for (int ks = 0; ks < 4; ++ks) acc = __builtin_amdgcn_mfma_f32_32x32x16_bf16(ca[ks], cb[ks], acc, 0, 0, 0);
        { LAS unsigned char* ot = L + par * 18432 + (w >> 2) * 9216;
#pragma unroll
          for (int i = 0; i < 16; ++i) *(LAS bf16*)(ot + (ti * 32 + ACC_ROW(i, lane)) * 144 + (vj * 32 + cl) * 2) = (bf16)f2bf(acc[i]); }
        __syncthreads();
        { const LAS unsigned char* ot = L + par * 18432 + (tid >> 8) * 9216 + tok * 144 + (tid & 3) * 32;
          float ro[2][8], ga[2][8], bo[2][8], wv[2][8], bb[2][8], out[8];
          unpack8(*(const LAS v4u*)ot, ro[0]); unpack8(*(const LAS v4u*)(ot + 16), ro[1]); unpack8(ga0, ga[0]); unpack8(ga1, ga[1]); unpack8(bv0, bo[0]); unpack8(bv1, bo[1]);
          load8f(lnw + chn, wv[0]); load8f(lnw + chn + 8, wv[1]); load8f(lnb + chn, bb[0]); load8f(lnb + chn + 8, bb[1]);
          float s1 = 0.f;
#pragma unroll
          for (int e = 0; e < 8; ++e) s1 += ro[0][e] + ro[1][e];
          const float mu = group_sum<4>(s1) * (1.f / 64.f); float s2 = 0.f;
#pragma unroll
          for (int q = 0; q < 2; ++q) {
#pragma unroll
              for (int e = 0; e < 8; ++e) { ro[q][e] -= mu; s2 += ro[q][e] * ro[q][e]; } }
          const float rs = __builtin_amdgcn_rsqf(group_sum<4>(s2) * (1.f / 64.f) + 64e-5f);
#pragma unroll
          for (int q = 0; q < 2; ++q) {
#pragma unroll
              for (int e = 0; e < 8; ++e) out[e] = (ro[q][e] * rs * wv[q][e] + bb[q][e] + bo[q][e] * bsc) * ga[q][e];
              *(v4u*)(MIX + tt * DM + 1024 + chn + q * 8) = pack8(out); } }
        par ^= 1;
    }
}
#undef RC_LOAD

__device__ __forceinline__ void odd_phase_b(Frame& F) {
    int tid = F.tid; OPAQUE_V(tid);
    const float* Um = scr_f(F, S_BU); float* osm = scr_f(F, S_OSM); bf16* Sbm = (bf16*)scr_f(F, S_BS);
    const float* U = scr_f(F, S_U); bf16* Sbl = (bf16*)scr_f(F, S_MS);
    constexpr size_t MLU = (size_t)ML_ROWS * 128;
    for (int e = F.bid * NTHREADS + tid; e < 131072; e += F.G * NTHREADS) {
        const int hb = e >> 13, pn = e & 8191;
        const int hm = e >> 15, vd = e & 32767; const bool extra = (vd >> 7) == 0; const int d = vd & 127;
        float Sb = 0.f, Sm = 0.f, Sx = 0.f, m = 0.f;
        for (int c0 = 0; c0 < NCHUNK; c0 += 16) { float ub[16], db[16], um[16], ux[16], bl[16], ml[16];
#pragma unroll
            for (int i = 0; i < 16; ++i) { const size_t ub_ = (size_t)(c0 + i) * 16 + hb, um_ = (size_t)(c0 + i) * 4 + hm;
                ub[i] = __builtin_nontemporal_load(Um + ub_ * 8192 + pn); db[i] = osm[ub_]; um[i] = __builtin_nontemporal_load(U + um_ * MLU + vd); ux[i] = extra ? __builtin_nontemporal_load(U + um_ * MLU + 32768 + d) : 0.f;        bl[i] = osm[OSM_BL + um_]; ml[i] = osm[OSM_ML + um_]; }
#pragma unroll
            for (int i = 0; i < 16; ++i) { const size_t ub_ = (size_t)(c0 + i) * 16 + hb, um_ = (size_t)(c0 + i) * 4 + hm;
                Sbm[ub_ * 8192 + pn] = (bf16)f2bf(Sb); Sb = db[i] * Sb + ub[i];
                Sbl[um_ * MLU + vd] = (bf16)f2bf(Sm); if (extra) Sbl[um_ * MLU + 32768 + d] = (bf16)f2bf(Sx); if (vd == 0) osm[OSM_MC + um_] = m;
                const float mn = fmaxf(bl[i] + m, ml[i]); const float cd = __expf(bl[i] + m - mn), ls = __expf(ml[i] - mn); Sm = cd * Sm + ls * um[i]; Sx = cd * Sx + ls * ux[i]; m = mn; } }
    }
}
#define RSUB(bit, stmt) do { for (int rq = 0; rq < ((((unsigned)(PROBE_REP)) >> (bit)) & 1u ? 2 : 1); ++rq) { __syncthreads(); stmt; } } while (0)
#define MIX_EVEN_A RSUB(16, hg_phase_a(F)); RSUB(17, rw_phase_a(F));
#define MIX_EVEN_B RSUB(18, rw_phase_b(F)); RSUB(19, hg_phase_b(F, F.G > 64 ? 32 : 0)); if (L + 1 < DEPTH && F.G >= 256) { __syncthreads(); phase_convert(F, args, L + 1, 32, F.G - 32, 3, 7); }
#define MIX_EVEN_C RSUB(20, hg_phase_c(F, F_IN(7) + (size_t)(L >> 1) * 1024)); RSUB(21, rw_phase_c(F, args, L));
#define MIX_ODD_A RSUB(22, ml_phase_a(F)); RSUB(23, mb_phase_a(F));
#define MIX_ODD_B RSUB(24, odd_phase_b(F));
#define MIX_ODD_C RSUB(25, ml_phase_c(F)); RSUB(26, mb_phase_c(F));

constexpr int NPHASE = 38;
__global__ void __launch_bounds__(NTHREADS, 2) trunk_fwd(Args args) {
    extern __shared__ __attribute__((aligned(16))) unsigned char lds[];
    Frame F;
    F.lds = (LAS unsigned char*)lds;
    F.MISC = (volatile LAS unsigned*)(F.lds + MISC_OFF);
    F.tid = threadIdx.x; F.lane = F.tid & 63; F.wave = __builtin_amdgcn_readfirstlane(F.tid >> 6);
    F.G = gridDim.x; F.bid = blockIdx.x; const int wave0 = F.wave;
    F.h = args.out; F.ws = args.ws;
    F.ctl = (gu32*)(args.ws + WS_CTL);
    for (int u = F.tid; u < (LDS_BYTES - LDSCTL_OFF) / 4; u += NTHREADS) ((LAS unsigned*)(F.lds + LDSCTL_OFF))[u] = 0u;
    __syncthreads();
    LAS float* const RTAB = (LAS float*)(F.lds + RTAB_OFF);
    const int lo = args.ph_lo, hi = args.ph_hi;
    const bool use_bar = (hi - lo) > 1;
    XcdBarrier bar; bar.bar = (unsigned*)(F.ctl + CW_BAR) + args.li * XCD_BAR_WORDS; bar.x = 0; bar.st = nullptr;
    if (use_bar) bar = xcd_barrier_post((unsigned*)(F.ctl + CW_BAR) + args.li * XCD_BAR_WORDS, F.MISC + 8);
#define LAUNDER() do { unsigned char* wsl = args.ws; asm volatile("" : "+s"(wsl)); F.ws = wsl; float* hl = args.out; asm volatile("" : "+s"(hl)); F.h = hl; int b_ = blockIdx.x, g_ = gridDim.x, w_ = wave0; asm volatile("" : "+s"(b_), "+s"(g_), "+s"(w_)); F.bid = b_; F.G = g_; F.wave = w_; int t_ = threadIdx.x; asm volatile("" : "+v"(t_)); F.tid = t_; F.lane = t_ & 63; } while (0)
#ifndef PROBE_REP
#define PROBE_REP 0
#endif
#define NREP(k) ((((PROBE_REP) >> (k)) & 1) ? 2 : 1)
#define IN(k) (lo <= (k) && (k) < hi)
#define SEAM(k) do { if (use_bar && (k) + 1 < hi) { xcd_barrier(bar); if ((PROBE_REP >> 14) & 1) xcd_barrier(bar); } } while (0)

    if (IN(0)) { LAUNDER(); if ((PROBE_REP >> 7) & 1) { for (int pl = 0; pl < 4; ++pl) probe_read_weights(F, args, pl); } phase_convert(F, args, 0, 0, F.G); phase_convert_lora(F, args); phase_x_init(F, F_IN(0), ws_bf(F, WS_XN), ssq_f(F, 0)); SEAM(0); }

    for (int pass2 = 0; pass2 < (((PROBE_REP) >> 13) & 1 ? 2 : 1); ++pass2) {
    if (pass2 > 0) { LAUNDER(); phase_x_init(F, F_IN(0), ws_bf(F, WS_XN), ssq_f(F, 0)); xcd_barrier(bar); }
    for (int L = 0; L < DEPTH; ++L) {
        const int pb = 1 + 9 * L, j = L >> 1; const bool odd = (L & 1) != 0;
        if (IN(pb + 0)) { LAUNDER();
            const bf16* W = odd ? ws_bf(F, WS_WINO) + (size_t)j * E_ODD_PAD * DM : ws_bf(F, WS_WINE) + (size_t)j * E_EVEN_PAD * DM;
            const int N = odd ? E_ODD_PAD : E_EVEN_PAD;
            pg8::Gemm g{ws_bf(F, WS_XN), W, SEQ, N, DM}; pg8::StaticOrder S; S.init(SEQ, N, F.G, F.bid);
            pg8::rstd_table_fill(RTAB, ssq_f(F, 2 * L), S, F.tid); pg8::EpiInProj E{ws_bf(F, WS_P), LDP, RTAB, odd ? 0 : 1, (const float*)(F.ws + WS_LB) + (size_t)L * 1024, (_Float16*)scr_f(F, S_HF), (bf16*)scr_f(F, S_HK)};
            for (int rp = 0; rp < NREP(1); ++rp) pg8::gemm_phase<pg8::EpiInProj, pg8::StaticOrder, true, true>(F.lds + RING_OFF, g, S, E);
            const int nin_ = (SEQ / 256) * (N / 256), fin_ = nin_ % F.G;
            const bool early_cvt = !odd && L + 1 < DEPTH && fin_ > 0 && F.G - fin_ >= 64;
            if (early_cvt) { __syncthreads(); phase_convert(F, args, L + 1, fin_, F.G - fin_, 7, 8); }
            SEAM(pb + 0);
        }
        if (IN(pb + 1)) { for (int rp = 0; rp < NREP(2); ++rp) { LAUNDER(); __syncthreads(); if (odd) RSUB(28, phase_odd_pre2(F, args, L)); else RSUB(27, phase_even_pre2(F, args, L)); } SEAM(pb + 1); }
        if (IN(pb + 2)) { for (int rp = 0; rp < NREP(3); ++rp) { LAUNDER(); __syncthreads(); if (odd) { MIX_ODD_A } else { MIX_EVEN_A } } SEAM(pb + 2); }
        if (IN(pb + 3)) { for (int rp = 0; rp < NREP(4); ++rp) { LAUNDER(); __syncthreads(); if (odd) { MIX_ODD_B } else { MIX_EVEN_B } } SEAM(pb + 3); }
        if (IN(pb + 4)) { for (int rp = 0; rp < NREP(5); ++rp) { LAUNDER(); __syncthreads(); if (odd) { MIX_ODD_C } else { MIX_EVEN_C } } SEAM(pb + 4); }
        if (IN(pb + 5) && odd) { for (int rp = 0; rp < NREP(6); ++rp) { LAUNDER(); __syncthreads(); RSUB(30, phase_odd_post2(F, args, L)); } SEAM(pb + 5); }
        if (IN(pb + 6)) { LAUNDER();
            const bf16* W = odd ? ws_bf(F, WS_WOUTO) + (size_t)j * DM * DM : ws_bf(F, WS_WOUTE) + (size_t)j * DM * DM;
            pg8::Gemm g{ws_bf(F, WS_MIX), W, SEQ, DM, DM}; pg8::StaticOrder S; S.init(SEQ, DM, F.G, F.bid);
            if (NREP(10) == 2) { pg8::EpiBf16P Ed{ws_bf(F, WS_P), LDP, RTAB}; pg8::gemm_phase<pg8::EpiBf16P, pg8::StaticOrder, true, true>(F.lds + RING_OFF, g, S, Ed); }
            pg8::EpiResBf16 E{ws_bf(F, WS_XN), DM, ssq_f(F, 2 * L + 1)};
            pg8::gemm_phase<pg8::EpiResBf16, pg8::StaticOrder, true, true>(F.lds + RING_OFF, g, S, E);
            SEAM(pb + 6);
        }
        if (IN(pb + 7)) { LAUNDER();
            pg8::Gemm g{ws_bf(F, WS_XN), ws_bf(F, WS_WUP) + (size_t)L * 2 * DFF * DM, SEQ, 2 * DFF, DM}; pg8::StaticOrder S; S.init(SEQ, 2 * DFF, F.G, F.bid);
            pg8::rstd_table_fill(RTAB, ssq_f(F, 2 * L + 1), S, F.tid); pg8::EpiSwiGLU E{ws_bf(F, WS_ACT), DFF, RTAB};
            for (int rp = 0; rp < NREP(9); ++rp) pg8::gemm_phase<pg8::EpiSwiGLU, pg8::StaticOrder, true, true>(F.lds + RING_OFF, g, S, E);
            if (L + 1 < DEPTH) { const int nun = (SEQ / 256) * (2 * DFF / 256), full = nun % F.G;
                if (full > 0 && full < F.G) { for (int rp = 0; rp < NREP(12); ++rp) { const int nie_ = (SEQ / 256) * (E_EVEN_PAD / 256) % F.G; const int hi_ = (!odd && nie_ > 0 && F.G - nie_ >= 64) ? (F.G >= 256 ? 3 : 7) : 8;        phase_convert(F, args, L + 1, full, F.G - full, 0, 3); __syncthreads(); if (hi_ > 3) phase_convert(F, args, L + 1, 0, F.G, 3, hi_); } }
                else { __syncthreads(); phase_convert(F, args, L + 1, 0, F.G); } }
            SEAM(pb + 7);
        }
        if (IN(pb + 8)) { LAUNDER();
            pg8::Gemm g{ws_bf(F, WS_ACT), ws_bf(F, WS_WDN) + (size_t)L * DM * DFF, SEQ, DM, DFF}; pg8::StaticOrder S; S.init(SEQ, DM, F.G, F.bid);
            if (NREP(11) == 2) { pg8::EpiBf16P Ed{ws_bf(F, WS_P), LDP, RTAB}; pg8::gemm_phase<pg8::EpiBf16P, pg8::StaticOrder, true, true>(F.lds + RING_OFF, g, S, Ed); }
            pg8::EpiResBf16 E{ws_bf(F, WS_XN), DM, ssq_f(F, 2 * L + 2)};
            pg8::gemm_phase<pg8::EpiResBf16, pg8::StaticOrder, true, true>(F.lds + RING_OFF, g, S, E);
            SEAM(pb + 8);
        }
    }
    }
    if (IN(NPHASE - 1)) { LAUNDER(); phase_final_norm(F, F_IN(3), ssq_f(F, 8), ws_bf(F, WS_XN)); }
#undef IN
#undef SEAM
}

#ifndef MK_CUTS
#define MK_CUTS 0
#endif
extern "C" void kernel_launch(void* const* d_in, const int* in_sizes, int n_in, void* d_out, int out_size, void* d_ws, size_t ws_size, hipStream_t stream) {
    static int grid = 0;
    if (grid == 0) {
        if (n_in != 32 || in_sizes[0] != SEQ * DM || out_size != SEQ * DM || ws_size < WS_END) { fprintf(stderr, "kernel_launch: unexpected shapes (n_in %d, in0 %d, out %d, ws %zu < %zu); nothing launched\n", n_in, n_in > 0 ? in_sizes[0] : -1, out_size, ws_size, (size_t)WS_END); grid = -1; return; }
        int dev = 0, cus = 0, per_cu = 0;
        if (hipGetDevice(&dev) != hipSuccess || hipDeviceGetAttribute(&cus, hipDeviceAttributeMultiprocessorCount, dev) != hipSuccess) { grid = -1; return; }
        if (hipFuncSetAttribute((const void*)trunk_fwd, hipFuncAttributeMaxDynamicSharedMemorySize, LDS_BYTES) != hipSuccess) { fprintf(stderr, "kernel_launch: hipFuncSetAttribute failed\n"); grid = -1; return; }
        if (hipOccupancyMaxActiveBlocksPerMultiprocessor(&per_cu, (const void*)trunk_fwd, NTHREADS, LDS_BYTES) != hipSuccess || per_cu < 1) { fprintf(stderr, "kernel_launch: occupancy query reports %d\n", per_cu); }
        (void)hipGetLastError();
        grid = cus;
    }
    if (grid < 0) return;
    if (hipMemsetAsync((char*)d_ws + WS_CTL, 0, CTL_ZERO_BYTES, stream) != hipSuccess) return;
    Args a{};
    for (int i = 0; i < 32; ++i) a.in[i] = (const float*)d_in[i];
    a.out = (float*)d_out; a.ws = (unsigned char*)d_ws;
#if MK_CUTS == 1
    a.ph_lo = 0; a.ph_hi = NPHASE; a.li = 0;
    hipLaunchKernelGGL(trunk_fwd, dim3(grid), dim3(NTHREADS), LDS_BYTES, stream, a);
#else
    for (int p = 0; p < NPHASE; ++p) { a.ph_lo = p; a.ph_hi = p + 1; a.li = 0; hipLaunchKernelGGL(trunk_fwd, dim3(grid), dim3(NTHREADS), LDS_BYTES, stream, a); }
#endif
}
```
